# Optimizing an MI355X kernel written in HIP

```python
import math
import numpy as np
import jax
import jax.numpy as jnp
from jax import lax

D_MODEL = 1024
BATCH = 32
SEQ = 256
DEPTH = 4
DEC_BATCH = 2
DEC_SEQ = 4096
PAST_LEN = 256

GRID_W = 64
MIX_W = D_MODEL
GROUP_W = MIX_W // 4
HEAD_DIM = 64
POOL_GROUPS = 4
POOL_GC = GROUP_W // POOL_GROUPS
POOL_WINDOWS = (2, 4, 8, 16)
NA_HEADS = GROUP_W // HEAD_DIM
NA_ROWS = 8
NA_COLS = 16
ATTN_BLOCK = 128
RET_HEADS = 4
RET_DK = GROUP_W // RET_HEADS
RET_DV = GROUP_W // RET_HEADS
RET_CHUNK = 128
GLA_HEADS = 4
GLA_DK = GROUP_W // (2 * GLA_HEADS)
GLA_DV = GROUP_W // GLA_HEADS
GLA_LOWRANK = 16
GLA_TAU = 16.0
GLA_CHUNK = 64
D_FF = -(-8 * D_MODEL // (3 * 256)) * 256
P_IN = GROUP_W + 3 * NA_HEADS * HEAD_DIM + 2 * RET_HEADS * (RET_DK + RET_DV) + 2 * GLA_HEADS * (GLA_DK + GLA_DV) + GLA_LOWRANK
ROPE_BASE = 10000.0
RMS_EPS = 1e-6
GN_EPS = 1e-5

kernel_name = 'hybrid_pool_na_ret_gla_diffusion_step'


def _split_points():
    sizes = (GROUP_W,
             NA_HEADS * HEAD_DIM, NA_HEADS * HEAD_DIM, NA_HEADS * HEAD_DIM,
             RET_HEADS * RET_DK, RET_HEADS * RET_DK, RET_HEADS * RET_DV, RET_HEADS * RET_DV,
             GLA_HEADS * GLA_DK, GLA_HEADS * GLA_DK, GLA_HEADS * GLA_DV, GLA_HEADS * GLA_DV,
             GLA_LOWRANK)
    return [int(s) for s in np.cumsum(sizes)[:-1]]


def _rmsnorm(x, g):
    xf = x.astype(jnp.float32)
    y = xf * lax.rsqrt(jnp.mean(xf * xf, axis=-1, keepdims=True) + RMS_EPS)
    return (y * g.astype(jnp.float32)).astype(x.dtype)


def _head_groupnorm(o):
    of = o.astype(jnp.float32)
    mu = jnp.mean(of, axis=-1, keepdims=True)
    var = jnp.mean(jnp.square(of - mu), axis=-1, keepdims=True)
    return ((of - mu) * lax.rsqrt(var + GN_EPS)).astype(o.dtype)


def _heads(t, n):
    return t.reshape(t.shape[:-1] + (n, t.shape[-1] // n))


def _rope_axis(x, pos):
    nf = x.shape[-1] // 2
    inv = (ROPE_BASE ** (-np.arange(nf, dtype=np.float32) / nf)).astype(np.float32)
    ang = pos.astype(np.float32)[:, None] * inv[None, :]
    cos = jnp.asarray(np.cos(ang), dtype=x.dtype)[None, :, None, :]
    sin = jnp.asarray(np.sin(ang), dtype=x.dtype)[None, :, None, :]
    x1, x2 = x[..., :nf], x[..., nf:]
    return jnp.concatenate([x1 * cos - x2 * sin, x1 * sin + x2 * cos], axis=-1)


def _rope_2d(x):
    n = x.shape[1]
    t = np.arange(n)
    half = x.shape[-1] // 2
    return jnp.concatenate([_rope_axis(x[..., :half], t // GRID_W),
                            _rope_axis(x[..., half:], t % GRID_W)], axis=-1)


def _pool_mix(v, w_pool, scale):
    L = v.shape[-2]
    vf = v.astype(jnp.float32)
    cs = jnp.cumsum(vf, axis=-2)
    cs = jnp.concatenate([jnp.zeros_like(cs[..., :1, :]), cs], axis=-2)
    t = np.arange(L)
    means = []
    for gi, win in enumerate(POOL_WINDOWS):
        left = win // 2
        lo = np.clip(t - left, 0, L).astype(np.int32)
        hi = np.clip(t - left + win, 0, L).astype(np.int32)
        csg = cs[..., gi * POOL_GC:(gi + 1) * POOL_GC]
        cnt = jnp.asarray((hi - lo).astype(np.float32))[:, None]
        means.append((jnp.take(csg, hi, axis=-2) - jnp.take(csg, lo, axis=-2)) / cnt)
    d = (jnp.concatenate(means, axis=-1) - vf).astype(v.dtype)
    d = d.reshape(d.shape[:-1] + (POOL_GROUPS, POOL_GC))
    y = jnp.einsum('...gc,gcd->...gd', d, w_pool)
    return y.reshape(y.shape[:-2] + (GROUP_W,)) * scale


def _ctx_attention(q, k, v):
    B, L, H, dh = q.shape
    nb = L // ATTN_BLOCK
    qb = q.reshape(B, nb, ATTN_BLOCK, H, dh).transpose(1, 0, 2, 3, 4)
    scale = dh ** -0.5

    def block(qi):
        s = jnp.einsum('bqhd,bkhd->bhqk', qi, k).astype(jnp.float32) * scale
        p = jax.nn.softmax(s, axis=-1).astype(v.dtype)
        return jnp.einsum('bhqk,bkhd->bqhd', p, v)

    o = lax.map(block, qb)
    return o.transpose(1, 0, 2, 3, 4).reshape(B, L, H * dh)


def _na_latent(q, k, v, k_ctx, v_ctx, rpb):
    B, N, H, dh = q.shape
    rows = N // GRID_W
    kr = min(NA_ROWS, rows)
    kc = NA_COLS
    cols = np.arange(GRID_W)
    c0 = np.clip(cols - kc // 2, 0, GRID_W - kc)
    col_idx = (c0[:, None] + np.arange(kc)[None, :]).astype(np.int32)
    dc = (col_idx - cols[:, None] + (NA_COLS - 1)).astype(np.int32)
    scale = dh ** -0.5
    qr = q.reshape(B, rows, GRID_W, H, dh).transpose(1, 0, 2, 3, 4)

    def one_row(args):
        r, q_row = args
        r0 = jnp.clip(r - kr // 2, 0, rows - kr)
        key_rows = r0 + jnp.arange(kr, dtype=jnp.int32)
        tok = key_rows[None, :, None] * GRID_W + col_idx[:, None, :]
        kw = k[:, tok]
        vw = v[:, tok]
        dr = key_rows - r + (NA_ROWS - 1)
        bias = rpb[:, dr[None, :, None], dc[:, None, :]].astype(jnp.float32)
        s_loc = jnp.einsum('bwhd,bwrchd->bhwrc', q_row, kw).astype(jnp.float32) * scale + bias
        s_ctx = jnp.einsum('bwhd,bmhd->bhwm', q_row, k_ctx).astype(jnp.float32) * scale
        s = jnp.concatenate([s_loc.reshape(B, H, GRID_W, kr * kc), s_ctx], axis=-1)
        p = jax.nn.softmax(s, axis=-1).astype(v.dtype)
        p_loc = p[..., :kr * kc].reshape(B, H, GRID_W, kr, kc)
        return (jnp.einsum('bhwrc,bwrchd->bwhd', p_loc, vw)
                + jnp.einsum('bhwm,bmhd->bwhd', p[..., kr * kc:], v_ctx))

    o = lax.map(one_row, (jnp.arange(rows, dtype=jnp.int32), qr))
    return o.transpose(1, 0, 2, 3, 4).reshape(B, N, H * dh)


def _retention_scan(q, k, v, log_g, s0):
    B, L, H, dk = q.shape
    dv = v.shape[-1]
    C = RET_CHUNK
    n = L // C

    def chunks(t):
        return t.reshape(B, n, C, H, t.shape[-1]).transpose(1, 0, 3, 2, 4)

    idx = np.arange(C, dtype=np.float32)
    diff = idx[:, None] - idx[None, :]
    lg = log_g[:, None, None]
    d_intra = jnp.where(diff >= 0, jnp.exp(np.maximum(diff, 0.0) * lg), 0.0).astype(q.dtype)
    d_q = jnp.exp((idx + 1.0)[None, :, None] * lg).astype(q.dtype)
    d_k = jnp.exp((C - 1.0 - idx)[None, :, None] * lg).astype(q.dtype)
    d_c = jnp.exp(C * lg).astype(q.dtype)

    def step(S, inp):
        qc, kc, vc = inp
        a = jnp.einsum('bhid,bhjd->bhij', qc, kc) * d_intra
        o = jnp.einsum('bhij,bhjv->bhiv', a, vc) + jnp.einsum('bhid,bhdv->bhiv', qc, S) * d_q
        S = S * d_c + jnp.einsum('bhjd,bhjv->bhdv', kc * d_k, vc)
        return S.astype(s0.dtype), o

    S, o = lax.scan(step, s0, (chunks(q), chunks(k), chunks(v)))
    return o.transpose(1, 0, 3, 2, 4).reshape(B, L, H, dv), S


def _retention(q, k, v, g, decay_logit, s0):
    q = q * (RET_DK ** -0.5)
    log_g = jax.nn.log_sigmoid(decay_logit.astype(jnp.float32))
    o_f, s_f = _retention_scan(q, k, v, log_g[0], s0[:, 0])
    o_b, s_b = _retention_scan(q[:, ::-1], k[:, ::-1], v[:, ::-1], log_g[1], s0[:, 1])
    o = _head_groupnorm(o_f + o_b[:, ::-1])
    o = o.reshape(g.shape) * jax.nn.silu(g)
    return o, jnp.stack([s_f, s_b], axis=1)


def _gla_scan(q, k, v, log_a, s0):
    B, L, H, dk = q.shape
    dv = v.shape[-1]
    C = GLA_CHUNK
    n = L // C

    def chunks(t):
        return t.reshape(B, n, C, H, t.shape[-1]).transpose(1, 0, 3, 2, 4)

    mask = np.tril(np.ones((C, C), dtype=bool))[:, :, None]

    def step(S, inp):
        qc, kc, vc, ac = inp
        b = jnp.cumsum(ac, axis=2)
        rel = jnp.where(mask, b[:, :, :, None, :] - b[:, :, None, :, :], -jnp.inf)
        a = jnp.einsum('bhid,bhjd,bhijd->bhij', qc, kc, jnp.exp(rel).astype(qc.dtype))
        o = (jnp.einsum('bhij,bhjv->bhiv', a, vc)
             + jnp.einsum('bhid,bhdv->bhiv', qc * jnp.exp(b).astype(qc.dtype), S))
        bl = b[:, :, -1:, :]
        S = (S * jnp.exp(bl[:, :, 0, :, None]).astype(S.dtype)
             + jnp.einsum('bhjd,bhjv->bhdv', kc * jnp.exp(bl - b).astype(kc.dtype), vc))
        return S.astype(s0.dtype), o

    S, o = lax.scan(step, s0, (chunks(q), chunks(k), chunks(v), chunks(log_a)))
    return o.transpose(1, 0, 3, 2, 4).reshape(B, L, H, dv), S


def _gla(q, k, v, g, lr, gate_up, gate_b, norm_g, s0):
    q = q * (GLA_DK ** -0.5)

    def log_gate(d):
        z = (lr @ gate_up[d] + gate_b[d]).astype(jnp.float32)
        return _heads(jax.nn.log_sigmoid(z) / GLA_TAU, GLA_HEADS)

    o_f, s_f = _gla_scan(q, k, v, log_gate(0), s0[:, 0])
    o_b, s_b = _gla_scan(q[:, ::-1], k[:, ::-1], v[:, ::-1], log_gate(1)[:, ::-1], s0[:, 1])
    o = _rmsnorm(o_f + o_b[:, ::-1], norm_g)
    o = o.reshape(g.shape) * jax.nn.silu(g)
    return o, jnp.stack([s_f, s_b], axis=1)


def _token_mixers(h, latent, w_in_l, pool_w_l, pool_scale_l, rpb_l, ret_logit_l, gla_up_l, gla_b_l,
                  gla_ng_l, ctx_k, ctx_v, ret_s0, gla_s0):
    B, L, _ = h.shape
    parts = jnp.split(h @ w_in_l, _split_points(), axis=-1)
    v_pool, na_q, na_k, na_v, r_q, r_k, r_v, r_g, a_q, a_k, a_v, a_g, a_lr = parts
    na_q, na_k, na_v = _heads(na_q, NA_HEADS), _heads(na_k, NA_HEADS), _heads(na_v, NA_HEADS)
    r_q, r_k, r_v = _heads(r_q, RET_HEADS), _heads(r_k, RET_HEADS), _heads(r_v, RET_HEADS)
    a_q, a_k, a_v = _heads(a_q, GLA_HEADS), _heads(a_k, GLA_HEADS), _heads(a_v, GLA_HEADS)
    if latent:
        rows = L // GRID_W
        o_pool = _pool_mix(v_pool.reshape(B, rows, GRID_W, GROUP_W), pool_w_l, pool_scale_l).reshape(B, L, GROUP_W)
        o_na = _na_latent(na_q, na_k, na_v, ctx_k, ctx_v, rpb_l)
        r_q, r_k = _rope_2d(r_q), _rope_2d(r_k)
    else:
        o_pool = _pool_mix(v_pool, pool_w_l, pool_scale_l)
        o_na = _ctx_attention(na_q, na_k, na_v)
        ret_s0 = jnp.zeros((B, 2, RET_HEADS, RET_DK, RET_DV), h.dtype)
        gla_s0 = jnp.zeros((B, 2, GLA_HEADS, GLA_DK, GLA_DV), h.dtype)
    o_ret, s_ret = _retention(r_q, r_k, r_v, r_g, ret_logit_l, ret_s0)
    o_gla, s_gla = _gla(a_q, a_k, a_v, a_g, a_lr, gla_up_l, gla_b_l, gla_ng_l, gla_s0)
    o = jnp.concatenate([o_pool, o_na, o_ret, o_gla], axis=-1)
    if latent:
        return o, None, None, None, None
    return o, na_k, na_v, s_ret, s_gla


def setup_inputs(seed: int = 0) -> dict:
    key = jax.random.key(seed)
    ks = jax.random.split(key, 26)
    f32 = jnp.float32
    D = D_MODEL

    def nrm(k, shape, s):
        return jax.random.normal(k, shape, f32) * s

    ret_base = np.log(2.0 ** (5 + np.arange(RET_HEADS)) - 1.0).astype(np.float32)
    return {
        'x_prompt': nrm(ks[0], (BATCH, SEQ, D), 1.0),
        'x_sample': nrm(ks[1], (DEC_BATCH, DEC_SEQ, D), 1.0),
        'cache_na_k': nrm(ks[2], (DEC_BATCH, DEPTH, PAST_LEN, NA_HEADS, HEAD_DIM), 1.0),
        'cache_na_v': nrm(ks[3], (DEC_BATCH, DEPTH, PAST_LEN, NA_HEADS, HEAD_DIM), 1.0),
        'state_ret': nrm(ks[4], (DEC_BATCH, DEPTH, 2, RET_HEADS, RET_DK, RET_DV), 1.0),
        'state_gla': nrm(ks[5], (DEC_BATCH, DEPTH, 2, GLA_HEADS, GLA_DK, GLA_DV), 1.0),
        'c': nrm(ks[6], (DEC_BATCH, D), 1.0),
        'c_ctx': nrm(ks[7], (D,), 1.0),
        'w_mod': nrm(ks[8], (DEPTH, D, 6 * D), D ** -0.5),
        'b_mod': nrm(ks[9], (DEPTH, 6 * D), 0.01),
        'g_pre_mix': 1.0 + nrm(ks[10], (DEPTH, D), 0.05),
        'g_post_mix': 1.0 + nrm(ks[11], (DEPTH, D), 0.05),
        'g_pre_ffn': 1.0 + nrm(ks[12], (DEPTH, D), 0.05),
        'g_post_ffn': 1.0 + nrm(ks[13], (DEPTH, D), 0.05),
        'w_in': nrm(ks[14], (DEPTH, D, P_IN), D ** -0.5),
        'w_out': nrm(ks[15], (DEPTH, MIX_W, D), MIX_W ** -0.5),
        'pool_w': nrm(ks[16], (DEPTH, POOL_GROUPS, POOL_GC, POOL_GC), POOL_GC ** -0.5),
        'pool_scale': 1.0 + nrm(ks[17], (DEPTH, GROUP_W), 0.05),
        'na_rpb': nrm(ks[18], (DEPTH, NA_HEADS, 2 * NA_ROWS - 1, 2 * NA_COLS - 1), 0.02),
        'ret_decay_logit': jnp.asarray(ret_base)[None, None, :] + nrm(ks[19], (DEPTH, 2, RET_HEADS), 0.1),
        'gla_gate_up': nrm(ks[20], (DEPTH, 2, GLA_LOWRANK, GLA_HEADS * GLA_DK), GLA_LOWRANK ** -0.5),
        'gla_gate_b': nrm(ks[21], (DEPTH, 2, GLA_HEADS * GLA_DK), 0.01),
        'gla_norm_g': 1.0 + nrm(ks[22], (DEPTH, GLA_DV), 0.05),
        'w_ffn_gate': nrm(ks[23], (DEPTH, D, D_FF), D ** -0.5),
        'w_ffn_up': nrm(ks[24], (DEPTH, D, D_FF), D ** -0.5),
        'w_ffn_down': nrm(ks[25], (DEPTH, D_FF, D), D_FF ** -0.5),
    }


def reference(x_prompt, x_sample, cache_na_k, cache_na_v, state_ret, state_gla, c, c_ctx,
              w_mod, b_mod, g_pre_mix, g_post_mix, g_pre_ffn, g_post_ffn, w_in, w_out,
              pool_w, pool_scale, na_rpb, ret_decay_logit, gla_gate_up, gla_gate_b, gla_norm_g,
              w_ffn_gate, w_ffn_up, w_ffn_down):

    def run_layer(l, x, cvec, latent, ctx_k, ctx_v, ret_s0, gla_s0):
        mod = jax.nn.silu(cvec) @ w_mod[l] + b_mod[l]
        sh1, sc1, gt1, sh2, sc2, gt2 = jnp.split(mod[:, None, :], 6, axis=-1)
        h = _rmsnorm(x, g_pre_mix[l]) * (1.0 + sc1) + sh1
        o, k_na, v_na, s_ret, s_gla = _token_mixers(
            h, latent, w_in[l], pool_w[l], pool_scale[l], na_rpb[l], ret_decay_logit[l],
            gla_gate_up[l], gla_gate_b[l], gla_norm_g[l], ctx_k, ctx_v, ret_s0, gla_s0)
        x = x + gt1 * _rmsnorm(o @ w_out[l], g_post_mix[l])
        h = _rmsnorm(x, g_pre_ffn[l]) * (1.0 + sc2) + sh2
        y = (jax.nn.silu(h @ w_ffn_gate[l]) * (h @ w_ffn_up[l])) @ w_ffn_down[l]
        x = x + gt2 * _rmsnorm(y, g_post_ffn[l])
        return x, k_na, v_na, s_ret, s_gla

    xp = x_prompt
    cvec_ctx = c_ctx[None, :]
    ks_list, vs_list, sr_list, sg_list = [], [], [], []
    for l in range(DEPTH):
        xp, k_na, v_na, s_r, s_g = run_layer(l, xp, cvec_ctx, False, None, None, None, None)
        ks_list.append(k_na)
        vs_list.append(v_na)
        sr_list.append(s_r)
        sg_list.append(s_g)

    xs = x_sample
    for l in range(DEPTH):
        xs, _, _, _, _ = run_layer(l, xs, c, True, cache_na_k[:, l], cache_na_v[:, l],
                                   state_ret[:, l], state_gla[:, l])

    new_cache_na_k = jnp.stack(ks_list, axis=1)
    new_cache_na_v = jnp.stack(vs_list, axis=1)
    new_state_ret = jnp.stack(sr_list, axis=1)
    new_state_gla = jnp.stack(sg_list, axis=1)
    return (xp, xs, new_cache_na_k, new_cache_na_v, new_state_ret, new_state_gla)
```

```cpp
#include <hip/hip_runtime.h>
#include <hip/hip_cooperative_groups.h>
#include <cstdio>
#include <cstdint>
namespace cg = cooperative_groups;

constexpr int T = 16384, TC = 8192, D = 1024, NP = 3072, PIN = 2832, DFF = 2816, N3 = 5632, DEPTH = 4;
constexpr int C_VP = 0, C_NQ = 256, C_NK = 512, C_NV = 768, C_RQ = 1024, C_RK = 1280, C_RV = 1536, C_RG = 1792, C_AQ = 2048, C_AK = 2176, C_AV = 2304, C_AG = 2560;
constexpr float RMS_EPS = 1e-6f, GN_EPS = 1e-5f;
enum { I_XP = 0, I_XS, I_CK, I_CV, I_SR, I_SG, I_C, I_CCTX, I_WMOD, I_BMOD, I_GPM, I_GQM, I_GPF, I_GQF, I_WIN, I_WOUT, I_POOLW, I_POOLS, I_RPB, I_RETL, I_GUP, I_GB, I_GNG, I_WG, I_WU, I_WD, N_IN };
constexpr size_t O_Y = 0, O_CK = (size_t)T * D, O_CV = O_CK + 8388608, O_SR = O_CV + 8388608, O_SG = O_SR + 4194304, O_END = O_SG + 2097152;
constexpr size_t MiB = 1u << 20;
constexpr size_t WS_CTL = 0, CTL_ZERO_BYTES = 1 * MiB;
constexpr size_t WS_MOD = 1 * MiB;
constexpr size_t WS_W1 = 2 * MiB, W1_L = (size_t)NP * D * 2;
constexpr size_t WS_W2 = WS_W1 + 4 * W1_L, W2_L = (size_t)D * D * 2;
constexpr size_t WS_W3 = WS_W2 + 4 * W2_L, W3_L = (size_t)N3 * D * 2;
constexpr size_t WS_W4 = WS_W3 + 4 * W3_L, W4_L = (size_t)D * DFF * 2;
constexpr size_t WS_H = WS_W4 + 4 * W4_L;
constexpr size_t WS_O = WS_H + (size_t)T * D * 2;
constexpr size_t WS_BIG = WS_O + (size_t)T * D * 2;
constexpr size_t WS_P = WS_BIG;
constexpr size_t WS_U3 = WS_BIG;
constexpr size_t WS_Y = WS_BIG + (size_t)T * NP * 2;
constexpr size_t WS_LG = WS_Y;
constexpr size_t WS_SCAN = WS_LG + (size_t)T * 256 * 4;
constexpr size_t WS_END = WS_SCAN + 96 * MiB;
namespace pg8 {
#define PG8_LAS __attribute__((address_space(3)))
typedef unsigned short bf16_t;
typedef short bf16x8 __attribute__((ext_vector_type(8)));
typedef float f32x4 __attribute__((ext_vector_type(4)));
typedef unsigned u32x4 __attribute__((ext_vector_type(4)));
constexpr int BM = 256, BK = 64, HALF = 128, HTB = HALF * BK * 2  , STAGE_BYTES = 8 * HTB, NXCD = 8, WGM = 8;

__host__ __device__ __forceinline__ int lds_byte(int r, int c) { const int st = (r >> 4) * 2 + (c >> 5), rr = r & 15, cc = c & 31, ob = rr * 64 + cc * 2; return st * 1024 + (ob ^ (((ob >> 9) & 1) << 5)); }
__host__ __device__ __forceinline__ void stage_rc(int b, int& R, int& C) { const int st = b / 1024, sb = b % 1024, swz = sb ^ (((sb >> 9) & 1) << 5); R = (st >> 1) * 16 + swz / 64; C = (st & 1) * 32 + (swz % 64) / 2; }
__host__ __device__ __forceinline__ int perm32(int rho) { const int n = rho >> 4, i = rho & 15; return 8 * (i >> 2) + 4 * n + (i & 3); }

struct Unit { int pm, pn; };
struct Gemm { const bf16_t* A; const bf16_t* Bt; int M, N, K; };

struct StaticOrder {
    int nM, nN, nwg, G, c;
    __host__ __device__ void init(int M, int N, int G_, int c_) { nM = M / BM; nN = N / BM; nwg = nM * nN; G = G_; c = c_; }
    __host__ __device__ bool next(int i, Unit& u) const {
        const long L = (long)i * G + c; if (L >= nwg) return false;
        int wgid = (int)L; { const int q = nwg / NXCD, r = nwg % NXCD, xcd = wgid % NXCD, off = wgid / NXCD; wgid = (xcd < r ? xcd * (q + 1) : r * (q + 1) + (xcd - r) * q) + off; }
        const int nig = WGM * nN, gid = wgid / nig, fm = gid * WGM, gsz = (nM - fm) < WGM ? (nM - fm) : WGM;
        u.pm = fm + ((wgid % nig) % gsz); u.pn = (wgid % nig) / gsz; return true;
    }
    __device__ __forceinline__ void a_ready(const Unit&) const {}
    __device__ __forceinline__ void done(const Unit&) const {}
};

__device__ __forceinline__ unsigned cvt_pk_bf16(float lo, float hi) { unsigned r; asm volatile("v_cvt_pk_bf16_f32 %0, %1, %2" : "=v"(r) : "v"(lo), "v"(hi)); return r; }
__device__ __forceinline__ float siluf(float x) { return x / (1.0f + __expf(-x)); }
__device__ __forceinline__ float logsigf(float z) { return fminf(z, 0.f) - log1pf(__expf(-fabsf(z))); }
struct EpiG1 {
    static constexpr bool PERM = true, AFTER_DRAIN = false;
    bf16_t* P; float* LG; float* outK; float* outV; const float* gate_b; int layer;
    __device__ __forceinline__ void operator()(const f32x4 (&acc)[2][2][4][2], const Unit& u, int wr, int wc, int fr, int fq) const {
        const int row0 = u.pm * BM + wr * 64 + fr; const int cl = wc * 32 + 8 * fq;
        if (u.pn < 11) {
#pragma unroll
            for (int ai = 0; ai < 2; ++ai)
#pragma unroll
                for (int m = 0; m < 4; ++m) { bf16_t* rowp = P + (size_t)(row0 + ai * HALF + m * 16) * 3072 + u.pn * BM + cl;
#pragma unroll
                    for (int bj = 0; bj < 2; ++bj) { const f32x4 v0 = acc[ai][bj][m][0], v1 = acc[ai][bj][m][1];
                        u32x4 w; w.x = cvt_pk_bf16(v0[0], v0[1]); w.y = cvt_pk_bf16(v0[2], v0[3]); w.z = cvt_pk_bf16(v1[0], v1[1]); w.w = cvt_pk_bf16(v1[2], v1[3]);
                        *(u32x4*)(rowp + bj * HALF) = w; } }
            if ((u.pn == 2 || u.pn == 3) && u.pm < 32) {
                float* dst = (u.pn == 2 ? outK : outV) + ((size_t)(u.pm * 4 + layer) * 256) * 256 + cl;
#pragma unroll
                for (int ai = 0; ai < 2; ++ai)
#pragma unroll
                    for (int m = 0; m < 4; ++m) { float* rowp = dst + (size_t)(wr * 64 + fr + ai * HALF + m * 16) * 256;
#pragma unroll
                        for (int bj = 0; bj < 2; ++bj) { *(f32x4*)(rowp + bj * HALF) = acc[ai][bj][m][0]; *(f32x4*)(rowp + bj * HALF + 4) = acc[ai][bj][m][1]; } }
            }
        } else {
            const float* gb = gate_b + layer * 256 + cl;
#pragma unroll
            for (int bj = 0; bj < 2; ++bj) { const f32x4 b0 = *(const f32x4*)(gb + bj * HALF), b1 = *(const f32x4*)(gb + bj * HALF + 4);
#pragma unroll
                for (int ai = 0; ai < 2; ++ai)
#pragma unroll
                    for (int m = 0; m < 4; ++m) { float* rowp = LG + (size_t)(row0 + ai * HALF + m * 16) * 256 + cl + bj * HALF;
                        f32x4 z0 = acc[ai][bj][m][0] + b0, z1 = acc[ai][bj][m][1] + b1;
#pragma unroll
                        for (int j = 0; j < 4; ++j) { z0[j] = logsigf(z0[j]) * 0.0625f; z1[j] = logsigf(z1[j]) * 0.0625f; }
                        *(f32x4*)rowp = z0; *(f32x4*)(rowp + 4) = z1; } }
        }
    }
};
struct EpiF32 {
    static constexpr bool PERM = false, AFTER_DRAIN = false;
    float* C; int ldc;
    __device__ __forceinline__ void operator()(const f32x4 (&acc)[2][2][4][2], const Unit& u, int wr, int wc, int fr, int fq) const {
        const int row0 = u.pm * BM + wr * 64 + fr, col0 = u.pn * BM + wc * 32 + 4 * fq;
#pragma unroll
        for (int ai = 0; ai < 2; ++ai)
#pragma unroll
            for (int m = 0; m < 4; ++m) { float* rowp = C + (size_t)(row0 + ai * HALF + m * 16) * ldc + col0;
#pragma unroll
                for (int bj = 0; bj < 2; ++bj)
#pragma unroll
                    for (int n = 0; n < 2; ++n) *(f32x4*)(rowp + bj * HALF + n * 16) = acc[ai][bj][m][n]; }
    }
};
struct EpiG3 {
    static constexpr bool PERM = true, AFTER_DRAIN = false;
    bf16_t* U;
    __device__ __forceinline__ void operator()(const f32x4 (&acc)[2][2][4][2], const Unit& u, int wr, int wc, int fr, int fq) const {
        const int row0 = u.pm * BM + wr * 64 + fr, col0 = u.pn * HALF + wc * 32 + 8 * fq;
#pragma unroll
        for (int ai = 0; ai < 2; ++ai)
#pragma unroll
            for (int m = 0; m < 4; ++m) { f32x4 v0, v1;
#pragma unroll
                for (int j = 0; j < 4; ++j) { v0[j] = siluf(acc[ai][0][m][0][j]) * acc[ai][1][m][0][j]; v1[j] = siluf(acc[ai][0][m][1][j]) * acc[ai][1][m][1][j]; }
                u32x4 w; w.x = cvt_pk_bf16(v0[0], v0[1]); w.y = cvt_pk_bf16(v0[2], v0[3]); w.z = cvt_pk_bf16(v1[0], v1[1]); w.w = cvt_pk_bf16(v1[2], v1[3]);
                *(u32x4*)(U + (size_t)(row0 + ai * HALF + m * 16) * 2816 + col0) = w; }
    }
};
template <class Epi, class Sched, bool ALIGN_EPI = false, bool SP2 = false>
__device__ __forceinline__ void gemm_phase(PG8_LAS unsigned char* lds, const Gemm g, const Sched& S, const Epi& E) {
    int tid_ = threadIdx.x; asm volatile("" : "+v"(tid_)); const int tid = tid_, wid = __builtin_amdgcn_readfirstlane(tid >> 6), lane = tid & 63, wr = wid >> 2, wc = wid & 3, fr = lane & 15, fq = lane >> 4;
    const int K = g.K, nt = K / BK;
    unsigned voffA[2], voffB[2];
#pragma unroll
    for (int i = 0; i < 2; ++i) { int R, C; stage_rc(tid * 16 + i * 8192, R, C); const int Rb = Epi::PERM ? ((R & ~31) + perm32(R & 31)) : R;
        voffA[i] = (unsigned)(R * K + C) * 2u; voffB[i] = (unsigned)(Rb * K + C) * 2u; }
    const size_t kstep = (size_t)(BK * 2);
    const size_t hstep = (size_t)HALF * K * 2;
    const size_t tstep = 2 * hstep;
    const unsigned ldsw = (unsigned)wid * 1024u;
    const int aoff = lds_byte(wr * 64 + fr, fq * 8), boff = lds_byte(wc * 32 + fr, fq * 8);
#define PG8_SA(b, h) (((b) * 2 + (h)) * HTB)
#define PG8_SB(b, h) ((4 + (b) * 2 + (h)) * HTB)
#define PG8_STAGE(bufoff, gbase, voff) do { _Pragma("unroll") for (int _i = 0; _i < 2; ++_i) \
        __builtin_amdgcn_global_load_lds((const unsigned*)((const char*)(gbase) + (voff)[_i]), (PG8_LAS unsigned*)(lds + (bufoff) + ldsw + _i * 8192), 16, 0, 0); } while (0)
#define PG8_LDA(dst, b, h) do { _Pragma("unroll") for (int m = 0; m < 4; ++m) _Pragma("unroll") for (int k = 0; k < 2; ++k) dst[m][k] = *(const PG8_LAS bf16x8*)(lds + PG8_SA(b, h) + aoff + m * 2048 + k * 1024); } while (0)
#define PG8_LDB(dst, b, h) do { _Pragma("unroll") for (int n = 0; n < 2; ++n) _Pragma("unroll") for (int k = 0; k < 2; ++k) dst[n][k] = *(const PG8_LAS bf16x8*)(lds + PG8_SB(b, h) + boff + n * 2048 + k * 1024); } while (0)
#define PG8_MMA(ai, bj, At, Bt) do { __builtin_amdgcn_s_setprio(1); _Pragma("unroll") for (int m = 0; m < 4; ++m) _Pragma("unroll") for (int n = 0; n < 2; ++n) _Pragma("unroll") for (int k = 0; k < 2; ++k) \
        acc[ai][bj][m][n] = __builtin_amdgcn_mfma_f32_16x16x32_bf16(Bt[n][k], At[m][k], acc[ai][bj][m][n], 0, 0, 0); __builtin_amdgcn_s_setprio(0); } while (0)
#define PG8_WAIT_V(n) asm volatile("s_waitcnt vmcnt(" #n ")" ::: "memory")
#define PG8_WAIT_L(n) asm volatile("s_waitcnt lgkmcnt(" #n ")" ::: "memory")
#define PG8_BAR __builtin_amdgcn_s_barrier()
#define PG8_SCHED __builtin_amdgcn_sched_barrier(0)
    Unit cur, nxt; int ui = 0;
    if (!S.next(0, cur)) return;
    f32x4 acc[2][2][4][2];
#pragma unroll
    for (int a = 0; a < 2; ++a)
#pragma unroll
        for (int b = 0; b < 2; ++b)
#pragma unroll
            for (int m = 0; m < 4; ++m)
#pragma unroll
                for (int n = 0; n < 2; ++n) acc[a][b][m][n] = (f32x4){0.f, 0.f, 0.f, 0.f};
    bf16x8 At[4][2], B0[2][2], B1[2][2];
    const char* cA = (const char*)g.A + (size_t)cur.pm * tstep; const char* cB = (const char*)g.Bt + (size_t)cur.pn * tstep;
    S.a_ready(cur);
    if constexpr (SP2) {
        PG8_STAGE(PG8_SB(0, 0), cB, voffB); PG8_STAGE(PG8_SB(0, 1), cB + hstep, voffB); PG8_STAGE(PG8_SA(0, 0), cA, voffA); PG8_STAGE(PG8_SA(0, 1), cA + hstep, voffA);
        if (wr == 1) PG8_BAR;
        PG8_WAIT_V(2); PG8_BAR;
        PG8_STAGE(PG8_SB(1, 0), cB + kstep, voffB); PG8_STAGE(PG8_SA(1, 0), cA + kstep, voffA); PG8_STAGE(PG8_SB(1, 1), cB + hstep + kstep, voffB);
        PG8_WAIT_V(6); PG8_BAR;
    } else {
        PG8_STAGE(PG8_SB(0, 0), cB, voffB); PG8_STAGE(PG8_SA(0, 0), cA, voffA); PG8_STAGE(PG8_SB(0, 1), cB + hstep, voffB); PG8_STAGE(PG8_SA(0, 1), cA + hstep, voffA);
        if (wr == 1) PG8_BAR;
        PG8_WAIT_V(4); PG8_BAR;
        PG8_STAGE(PG8_SB(1, 0), cB + kstep, voffB); PG8_STAGE(PG8_SA(1, 0), cA + kstep, voffA); PG8_STAGE(PG8_SB(1, 1), cB + hstep + kstep, voffB);
        PG8_WAIT_V(6); PG8_BAR;
    }
    for (;;) {
        const bool has_next = S.next(ui + 1, nxt);
        const char* nA = has_next ? (const char*)g.A + (size_t)nxt.pm * tstep : cA; const char* nB = has_next ? (const char*)g.Bt + (size_t)nxt.pn * tstep : cB;
        for (int t = 0; t < nt; t += 2) {
            const bool last = (t == nt - 2);
            const char* a1 = cA + (size_t)(t + 1) * kstep;
            const char* a2 = last ? nA : cA + (size_t)(t + 2) * kstep; const char* b2 = last ? nB : cB + (size_t)(t + 2) * kstep;
            const char* a3 = a2 + kstep; const char* b3 = b2 + kstep;
            if (last && has_next) S.a_ready(nxt);
            if constexpr (SP2) {
            PG8_LDB(B0, 0, 0); PG8_LDB(B1, 0, 1); PG8_SCHED; PG8_LDA(At, 0, 0); PG8_STAGE(PG8_SA(1, 1), a1 + hstep, voffA);
            PG8_WAIT_V(8); PG8_WAIT_L(0); PG8_BAR; PG8_MMA(0, 0, At, B0); PG8_MMA(0, 1, At, B1); PG8_BAR; PG8_SCHED;
            PG8_LDA(At, 0, 1); PG8_STAGE(PG8_SB(0, 0), b2, voffB); PG8_STAGE(PG8_SB(0, 1), b2 + hstep, voffB); PG8_STAGE(PG8_SA(0, 0), a2, voffA);
            PG8_WAIT_V(8); PG8_WAIT_L(0); PG8_BAR; PG8_MMA(1, 0, At, B0); PG8_MMA(1, 1, At, B1); PG8_BAR; PG8_SCHED;
            PG8_LDB(B0, 1, 0); PG8_LDB(B1, 1, 1); PG8_SCHED; PG8_LDA(At, 1, 0); PG8_STAGE(PG8_SA(0, 1), a2 + hstep, voffA);
            PG8_WAIT_V(8); PG8_WAIT_L(0); PG8_BAR; PG8_MMA(0, 0, At, B0); PG8_MMA(0, 1, At, B1); PG8_BAR; PG8_SCHED;
            PG8_LDA(At, 1, 1); PG8_STAGE(PG8_SB(1, 0), b3, voffB); PG8_STAGE(PG8_SB(1, 1), b3 + hstep, voffB); PG8_STAGE(PG8_SA(1, 0), a3, voffA);
            PG8_WAIT_V(8); PG8_WAIT_L(0); PG8_BAR; PG8_MMA(1, 0, At, B0); PG8_MMA(1, 1, At, B1); PG8_BAR; PG8_SCHED;
            } else {
            PG8_LDB(B0, 0, 0); PG8_SCHED; PG8_LDA(At, 0, 0); PG8_STAGE(PG8_SA(1, 1), a1 + hstep, voffA);
            PG8_WAIT_L(8); PG8_BAR; PG8_WAIT_L(0); PG8_MMA(0, 0, At, B0); PG8_BAR; PG8_SCHED;
            PG8_LDB(B1, 0, 1); PG8_STAGE(PG8_SB(0, 0), b2, voffB);
            PG8_BAR; PG8_WAIT_L(0); PG8_MMA(0, 1, At, B1); PG8_BAR;
            PG8_LDA(At, 0, 1); PG8_STAGE(PG8_SA(0, 0), a2, voffA);
            PG8_BAR; PG8_WAIT_L(0); PG8_MMA(1, 0, At, B0); PG8_BAR; PG8_SCHED;
            PG8_STAGE(PG8_SB(0, 1), b2 + hstep, voffB);
            PG8_WAIT_V(6); PG8_BAR; PG8_MMA(1, 1, At, B1); PG8_BAR;
            PG8_LDB(B0, 1, 0); PG8_SCHED; PG8_LDA(At, 1, 0); PG8_STAGE(PG8_SA(0, 1), a2 + hstep, voffA);
            PG8_WAIT_L(8); PG8_BAR; PG8_WAIT_L(0); PG8_MMA(0, 0, At, B0); PG8_BAR; PG8_SCHED;
            PG8_LDB(B1, 1, 1); PG8_STAGE(PG8_SB(1, 0), b3, voffB);
            PG8_BAR; PG8_WAIT_L(0); PG8_MMA(0, 1, At, B1); PG8_BAR;
            PG8_LDA(At, 1, 1); PG8_STAGE(PG8_SA(1, 0), a3, voffA);
            PG8_BAR; PG8_WAIT_L(0); PG8_MMA(1, 0, At, B0); PG8_BAR; PG8_SCHED;
            PG8_STAGE(PG8_SB(1, 1), b3 + hstep, voffB);
            PG8_WAIT_V(6); PG8_BAR; PG8_MMA(1, 1, At, B1); PG8_BAR;
            }
        }
        if constexpr (ALIGN_EPI) { if (wr == 0) PG8_BAR; }
        if constexpr (!Epi::AFTER_DRAIN) { E(acc, cur, wr, wc, fr, fq); S.done(cur); }
        if (!has_next) break;
#pragma unroll
        for (int a = 0; a < 2; ++a)
#pragma unroll
            for (int b = 0; b < 2; ++b)
#pragma unroll
                for (int m = 0; m < 4; ++m)
#pragma unroll
                    for (int n = 0; n < 2; ++n) acc[a][b][m][n] = (f32x4){0.f, 0.f, 0.f, 0.f};
        cur = nxt; cA = nA; cB = nB; ++ui;
        if constexpr (ALIGN_EPI) { if (wr == 1) PG8_BAR; }
    }
    PG8_WAIT_V(0);
    if constexpr (!ALIGN_EPI) { if (wr == 0) PG8_BAR; }
    PG8_BAR;
    if constexpr (Epi::AFTER_DRAIN) { E.fused(acc, cur, wr, wc, fr, fq, lds, wid, lane); S.done(cur); }
#undef PG8_SA
#undef PG8_SB
#undef PG8_STAGE
#undef PG8_LDA
#undef PG8_LDB
#undef PG8_MMA
#undef PG8_WAIT_V
#undef PG8_WAIT_L
#undef PG8_BAR
#undef PG8_SCHED
}
}
constexpr int NWAVES = 8, NTHR = 512;
constexpr int RING_OFF = 0, RING_BYTES = 131072;
constexpr int LDSCTL_OFF = RING_BYTES, MISC_OFF = LDSCTL_OFF + 320;
constexpr int LDS_BYTES = 147456;
#define GAS __attribute__((address_space(1)))
#define LAS __attribute__((address_space(3)))
typedef unsigned short bf16;
typedef unsigned v4u __attribute__((ext_vector_type(4)));
typedef unsigned v2u __attribute__((ext_vector_type(2)));
typedef float f32x4 __attribute__((ext_vector_type(4)));
typedef short bf16x8 __attribute__((ext_vector_type(8)));
#define LDS_WAIT() asm volatile("s_waitcnt lgkmcnt(0)" ::: "memory")
#define VM_WAIT() asm volatile("s_waitcnt vmcnt(0)" ::: "memory")
__device__ __forceinline__ unsigned f2bf(float f) { unsigned u = __builtin_bit_cast(unsigned, f); return (u + 0x7fffu + ((u >> 16) & 1u)) >> 16; }
__device__ __forceinline__ unsigned pk2(float lo, float hi) { return f2bf(lo) | (f2bf(hi) << 16); }
__device__ __forceinline__ float bf2f(bf16 b) { return __builtin_bit_cast(float, (unsigned)b << 16); }
__device__ __forceinline__ float wave_sum(float v) {
#pragma unroll
    for (int o = 1; o < 64; o <<= 1) v += __shfl_xor(v, o);
    return v;
}
__device__ __forceinline__ float siluf(float x) { return x / (1.0f + __expf(-x)); }
__device__ __forceinline__ int opaque_tid() { int t = threadIdx.x; asm volatile("" : "+v"(t)); return t; }

struct Args { const float* in[N_IN]; float* out; unsigned char* ws; int ph_lo, ph_hi, coop, pad; };

constexpr int NPH = 2 + 9 * DEPTH;

__device__ __forceinline__ void p0_transpose_item(const float* W, int ldw, int k0, int n_src0, bf16* WT, int Kdst, int dst_row0, float scale, LAS float* scr, int lane) {
#pragma unroll 8
    for (int i = 0; i < 32; ++i) { const int kk = 2 * i + (lane >> 5); scr[kk * 33 + (lane & 31)] = W[(size_t)(k0 + kk) * ldw + n_src0 + (lane & 31)]; }
    LDS_WAIT(); asm volatile("" ::: "memory");
    const int c = lane & 7;
#pragma unroll
    for (int j = 0; j < 4; ++j) { const int n = (lane >> 3) + 8 * j; const LAS float* s = scr + (8 * c) * 33 + n;
        v4u o; o.x = pk2(s[0 * 33] * scale, s[1 * 33] * scale); o.y = pk2(s[2 * 33] * scale, s[3 * 33] * scale); o.z = pk2(s[4 * 33] * scale, s[5 * 33] * scale); o.w = pk2(s[6 * 33] * scale, s[7 * 33] * scale);
        *(GAS v4u*)(WT + (size_t)(dst_row0 + n) * Kdst + k0 + 8 * c) = o; }
    LDS_WAIT(); asm volatile("" ::: "memory");
}

__device__ __forceinline__ void phase_p0a(const Args& a, LAS unsigned char* lds) {
    const int tid = opaque_tid(), lane = tid & 63, wave = tid >> 6;
    const int G = gridDim.x, gw = blockIdx.x * NWAVES + wave, NGW = G * NWAVES;
    unsigned char* ws = a.ws;
    LAS float* scr = (LAS float*)(lds + wave * 16384);
    constexpr int IT_IN = 16 * 88, IT_OUT = 16 * 32, IT_G = 16 * 88, IT_D = 44 * 32, IT_L = IT_IN + IT_OUT + 2 * IT_G + IT_D;
    for (int it = gw; it < DEPTH * IT_L; it += NGW) {
        const int l = it / IT_L; int r = it % IT_L;
        if (r < IT_IN) { const int kb = r / 88, nb = r % 88, n0 = nb * 32;
            const float sc = (n0 >= C_NQ && n0 < C_NK) ? 0.125f : (n0 >= C_RQ && n0 < C_RK) ? 0.125f : (n0 >= C_AQ && n0 < C_AK) ? 0.17677669529663687f : 1.0f;
            p0_transpose_item(a.in[I_WIN] + (size_t)l * D * PIN, PIN, kb * 64, n0, (bf16*)(ws + WS_W1 + l * W1_L), D, n0, sc, scr, lane); continue; }
        r -= IT_IN;
        if (r < IT_OUT) { const int kb = r / 32, nb = r % 32;
            p0_transpose_item(a.in[I_WOUT] + (size_t)l * D * D, D, kb * 64, nb * 32, (bf16*)(ws + WS_W2 + l * W2_L), D, nb * 32, 1.0f, scr, lane); continue; }
        r -= IT_OUT;
        if (r < 2 * IT_G) { const int up = r >= IT_G; if (up) r -= IT_G; const int kb = r / 88, nb = r % 88, n0 = nb * 32;
            p0_transpose_item((up ? a.in[I_WU] : a.in[I_WG]) + (size_t)l * D * DFF, DFF, kb * 64, n0, (bf16*)(ws + WS_W3 + l * W3_L), D, (n0 >> 7) * 256 + (up ? 128 : 0) + (n0 & 127), 1.0f, scr, lane); continue; }
        r -= 2 * IT_G;
        { const int kb = r / 32, nb = r % 32;
            p0_transpose_item(a.in[I_WD] + (size_t)l * DFF * D, D, kb * 64, nb * 32, (bf16*)(ws + WS_W4 + l * W4_L), DFF, nb * 32, 1.0f, scr, lane); }
    }
    for (int i = blockIdx.x * NTHR + tid; i < DEPTH * 256 * D; i += G * NTHR) {
        const int k = i & (D - 1), dj = (i >> 10) & 255, l = i >> 18;
        const float* wr = a.in[I_WIN] + ((size_t)l * D + k) * PIN + 2816; const float* gu = a.in[I_GUP] + (size_t)l * 2 * 16 * 128 + (dj >> 7) * 16 * 128 + (dj & 127);
        float s = 0.f;
#pragma unroll
        for (int r = 0; r < 16; ++r) s += wr[r] * gu[r * 128];
        ((bf16*)(ws + WS_W1 + l * W1_L))[(size_t)(2816 + dj) * D + k] = (bf16)f2bf(s);
    }
    __syncthreads();
    LAS float* sc = (LAS float*)lds;
    LAS float* red = (LAS float*)(lds + 16384);
    for (int i = tid; i < 3 * D; i += NTHR) { const int v = i >> 10, k = i & (D - 1); const float x = v == 0 ? a.in[I_CCTX][k] : a.in[I_C][(v - 1) * D + k]; sc[i] = siluf(x); }
    __syncthreads();
    float* MOD = (float*)(ws + WS_MOD);
    for (int it = blockIdx.x; it < DEPTH * 96; it += G) {
        const int l = it / 96, n0 = (it % 96) * 64;
        const float* w = a.in[I_WMOD] + (size_t)l * D * 6144 + (size_t)(wave * 128) * 6144 + n0 + lane;
        float a0 = 0.f, a1 = 0.f, a2 = 0.f;
#pragma unroll 8
        for (int k = 0; k < 128; ++k) { const float x = w[(size_t)k * 6144]; const int kk = wave * 128 + k; a0 += sc[kk] * x; a1 += sc[D + kk] * x; a2 += sc[2 * D + kk] * x; }
        red[(wave * 3 + 0) * 64 + lane] = a0; red[(wave * 3 + 1) * 64 + lane] = a1; red[(wave * 3 + 2) * 64 + lane] = a2;
        __syncthreads();
        if (tid < 192) { const int v = tid >> 6; float s = 0.f;
#pragma unroll
            for (int w8 = 0; w8 < 8; ++w8) s += red[(w8 * 3 + v) * 64 + lane];
            MOD[((size_t)l * 3 + v) * 6144 + n0 + lane] = s + a.in[I_BMOD][l * 6144 + n0 + lane]; }
        __syncthreads();
    }
}

__device__ __forceinline__ const float* mod_row(const Args& a, int l, int row) { const int mv = row < TC ? 0 : 1 + ((row - TC) >> 12); return (const float*)(a.ws + WS_MOD) + ((size_t)l * 3 + mv) * 6144; }
__device__ __forceinline__ const float* xin_row(const Args& a, int row) { return row < TC ? a.in[I_XP] + (size_t)row * D : a.in[I_XS] + (size_t)(row - TC) * D; }
__device__ __forceinline__ void phase_p0b(const Args& a) {
    const int tid = opaque_tid(), lane = tid & 63, wave = tid >> 6;
    const int gw = blockIdx.x * NWAVES + wave, NGW = gridDim.x * NWAVES;
    bf16* H = (bf16*)(a.ws + WS_H);
    for (int row = gw; row < T; row += NGW) {
        const float* mod = mod_row(a, 0, row);
        const f32x4* xr = (const f32x4*)xin_row(a, row) + lane;
        f32x4 v[4]; float s = 0.f;
#pragma unroll
        for (int j = 0; j < 4; ++j) { v[j] = xr[64 * j]; s += (v[j].x * v[j].x + v[j].y * v[j].y) + (v[j].z * v[j].z + v[j].w * v[j].w); }
        const float rstd = 1.0f / sqrtf(wave_sum(s) * (1.f / D) + RMS_EPS);
        unsigned long long* o8 = (unsigned long long*)(H + (size_t)row * D) + lane;
#pragma unroll
        for (int j = 0; j < 4; ++j) { const int c = 4 * lane + 256 * j;
            const f32x4 g = *(const f32x4*)(a.in[I_GPM] + c), sh = *(const f32x4*)(mod + c), scl = *(const f32x4*)(mod + D + c);
            const f32x4 h = v[j] * rstd * g * (scl + 1.0f) + sh;
            o8[64 * j] = (unsigned long long)pk2(h.x, h.y) | ((unsigned long long)pk2(h.z, h.w) << 32); }
    }
}
__device__ __forceinline__ void phase_rowpass(const Args& a, int l, int which) {
    const int tid = opaque_tid(), lane = tid & 63, wave = tid >> 6;
    const int gw = blockIdx.x * NWAVES + wave, NGW = gridDim.x * NWAVES;
    bf16* H = (bf16*)(a.ws + WS_H); const float* Y = (const float*)(a.ws + WS_Y);
    const float* gpost = (which ? a.in[I_GQF] : a.in[I_GQM]) + l * D;
    const bool need_h = (which == 0) || (l + 1 < DEPTH);
    const float* gpre = which == 0 ? a.in[I_GPF] + l * D : a.in[I_GPM] + (l + 1 < DEPTH ? l + 1 : l) * D;
    for (int row = gw; row < T; row += NGW) {
        const float* mod = mod_row(a, l, row);
        const float* modn = which == 0 ? mod : mod_row(a, l + 1 < DEPTH ? l + 1 : l, row);
        const f32x4* yr = (const f32x4*)(Y + (size_t)row * D) + lane;
        const f32x4* xr = (l == 0 && which == 0) ? (const f32x4*)xin_row(a, row) + lane : (const f32x4*)(a.out + (size_t)row * D) + lane;
        f32x4 y[4], x[4]; float s = 0.f;
#pragma unroll
        for (int j = 0; j < 4; ++j) { y[j] = yr[64 * j]; x[j] = xr[64 * j]; s += (y[j].x * y[j].x + y[j].y * y[j].y) + (y[j].z * y[j].z + y[j].w * y[j].w); }
        const float rstd = 1.0f / sqrtf(wave_sum(s) * (1.f / D) + RMS_EPS);
        float s2 = 0.f;
        f32x4* xo = (f32x4*)(a.out + (size_t)row * D) + lane;
#pragma unroll
        for (int j = 0; j < 4; ++j) { const int c = 4 * lane + 256 * j;
            const f32x4 g = *(const f32x4*)(gpost + c), gt = *(const f32x4*)(mod + (which ? 5 : 2) * D + c);
            x[j] = x[j] + gt * (y[j] * rstd * g);
            xo[64 * j] = x[j];
            s2 += (x[j].x * x[j].x + x[j].y * x[j].y) + (x[j].z * x[j].z + x[j].w * x[j].w); }
        if (need_h) {
            const float rstd2 = 1.0f / sqrtf(wave_sum(s2) * (1.f / D) + RMS_EPS);
            unsigned long long* o8 = (unsigned long long*)(H + (size_t)row * D) + lane;
#pragma unroll
            for (int j = 0; j < 4; ++j) { const int c = 4 * lane + 256 * j;
                const f32x4 g = *(const f32x4*)(gpre + c), sh = *(const f32x4*)(modn + (which == 0 ? 3 : 0) * D + c), scl = *(const f32x4*)(modn + (which == 0 ? 4 : 1) * D + c);
                const f32x4 h = x[j] * rstd2 * g * (scl + 1.0f) + sh;
                o8[64 * j] = (unsigned long long)pk2(h.x, h.y) | ((unsigned long long)pk2(h.z, h.w) << 32); }
        }
    }
}
__global__ void nv_rope(const bf16* P, float* RQ, float* RK) {
    const int i = blockIdx.x * blockDim.x + threadIdx.x;
    if (i >= 8192 * 4 * 2 * 16) return;
    const int j = i & 15, half = (i >> 4) & 1, h = (i >> 5) & 3, tl = i >> 7;
    const int n = tl & 4095, pos = half ? (n & 63) : (n >> 6);
    const float inv = powf(10000.0f, -(float)j / 16.0f), ang = (float)pos * inv, cs = cosf(ang), sn = sinf(ang);
    const int c = h * 64 + half * 32 + j;
    const bf16* p = P + (size_t)(TC + tl) * 3072;
    { const float x1 = bf2f(p[C_RQ + c]), x2 = bf2f(p[C_RQ + c + 16]); RQ[(size_t)tl * 256 + c] = x1 * cs - x2 * sn; RQ[(size_t)tl * 256 + c + 16] = x1 * sn + x2 * cs; }
    { const float x1 = bf2f(p[C_RK + c]), x2 = bf2f(p[C_RK + c + 16]); RK[(size_t)tl * 256 + c] = x1 * cs - x2 * sn; RK[(size_t)tl * 256 + c + 16] = x1 * sn + x2 * cs; }
}
__global__ void nv_pool(const bf16* P, bf16* O, const float* pool_w, const float* pool_scale) {
    __shared__ float sd[256];
    const int t = blockIdx.x, c = threadIdx.x, g = c >> 6;
    int pos, L; if (t < TC) { pos = t & 255; L = 256; } else { pos = (t - TC) & 63; L = 64; }
    const int base = t - pos, win = 2 << g, left = win >> 1;
    const int lo = max(pos - left, 0), hi = min(pos - left + win, L);
    float s = 0.f; for (int p = lo; p < hi; ++p) s += bf2f(P[(size_t)(base + p) * 3072 + C_VP + c]);
    sd[c] = s / (float)(hi - lo) - bf2f(P[(size_t)t * 3072 + C_VP + c]);
    __syncthreads();
    const int d = c & 63; float y = 0.f;
    for (int cc = 0; cc < 64; ++cc) y += sd[g * 64 + cc] * pool_w[(g * 64 + cc) * 64 + d];
    O[(size_t)t * 1024 + c] = (bf16)f2bf(y * pool_scale[c]);
}
__global__ void nv_attn_ctx(const bf16* P, bf16* O) {
    __shared__ float sq[64], sc[256];
    const int t = blockIdx.x >> 2, h = blockIdx.x & 3, b = t >> 8, tid = threadIdx.x;
    sq[tid] = bf2f(P[(size_t)t * 3072 + C_NQ + h * 64 + tid]);
    __syncthreads();
    for (int k = tid; k < 256; k += 64) { const bf16* kp = P + (size_t)(b * 256 + k) * 3072 + C_NK + h * 64; float s = 0.f; for (int d = 0; d < 64; ++d) s += sq[d] * bf2f(kp[d]); sc[k] = s; }
    __syncthreads();
    float mx = -1e30f; for (int k = 0; k < 256; ++k) mx = fmaxf(mx, sc[k]);
    float sum = 0.f, o = 0.f;
    for (int k = 0; k < 256; ++k) { const float p = __expf(sc[k] - mx); sum += p; o += p * bf2f(P[(size_t)(b * 256 + k) * 3072 + C_NV + h * 64 + tid]); }
    O[(size_t)t * 1024 + 256 + h * 64 + tid] = (bf16)f2bf(o / sum);
}
__global__ void nv_attn_lat(const bf16* P, bf16* O, const float* ck, const float* cv, const float* rpb, int l) {
    __shared__ float sq[64], sc[384];
    const int tl = blockIdx.x >> 2, h = blockIdx.x & 3, b = tl >> 12, n = tl & 4095, r = n >> 6, w = n & 63, tid = threadIdx.x;
    const int r0 = min(max(r - 4, 0), 56), c0 = min(max(w - 8, 0), 48);
    sq[tid] = bf2f(P[(size_t)(TC + tl) * 3072 + C_NQ + h * 64 + tid]);
    __syncthreads();
    for (int i = tid; i < 384; i += 64) {
        float s = 0.f;
        if (i < 128) { const int kr = r0 + (i >> 4), kc = c0 + (i & 15); const bf16* kp = P + (size_t)(TC + b * 4096 + kr * 64 + kc) * 3072 + C_NK + h * 64;
            for (int d = 0; d < 64; ++d) s += sq[d] * bf2f(kp[d]);
            s += rpb[((size_t)(l * 4 + h) * 15 + (kr - r + 7)) * 31 + (kc - w + 15)]; }
        else { const float* kp = ck + ((size_t)(b * 4 + l) * 256 + (i - 128)) * 256 + h * 64; for (int d = 0; d < 64; ++d) s += sq[d] * kp[d]; }
        sc[i] = s; }
    __syncthreads();
    float mx = -1e30f; for (int i = 0; i < 384; ++i) mx = fmaxf(mx, sc[i]);
    float sum = 0.f, o = 0.f;
    for (int i = 0; i < 384; ++i) { const float p = __expf(sc[i] - mx); sum += p; float v;
        if (i < 128) { const int kr = r0 + (i >> 4), kc = c0 + (i & 15); v = bf2f(P[(size_t)(TC + b * 4096 + kr * 64 + kc) * 3072 + C_NV + h * 64 + tid]); }
        else v = cv[((size_t)(b * 4 + l) * 256 + (i - 128)) * 256 + h * 64 + tid];
        o += p * v; }
    O[(size_t)(TC + tl) * 1024 + 256 + h * 64 + tid] = (bf16)f2bf(o / sum);
}
template <int DK, bool GLA>
__global__ void nv_scan(const bf16* P, const float* RQ, const float* RK, const float* LG, const float* s0, const float* decay_logit, float* OF, float* OB, float* out_state, int l) {
    __shared__ float sq[64][DK], sk[64][DK], sa[GLA ? 64 : 1][DK], sv[64][64];
    const int dir = blockIdx.x & 1, h = (blockIdx.x >> 1) & 3, seq = blockIdx.x >> 3, v = threadIdx.x;
    const bool lat = seq >= 32; const int L = lat ? 4096 : 256, base = lat ? TC + (seq - 32) * 4096 : seq * 256;
    float S[DK];
#pragma unroll
    for (int d = 0; d < DK; ++d) S[d] = lat ? s0[((((size_t)(seq - 32) * 4 + l) * 2 + dir) * 4 + h) * DK * 64 + d * 64 + v] : 0.f;
    float gam = 1.f; if (!GLA) gam = 1.0f / (1.0f + __expf(-decay_logit[(l * 2 + dir) * 4 + h]));
    float* OD = dir ? OB : OF;
    const int cq = GLA ? C_AQ + h * DK : C_RQ + h * DK, ck_ = GLA ? C_AK + h * DK : C_RK + h * DK, cvv = GLA ? C_AV + h * 64 : C_RV + h * 64;
    for (int c0 = 0; c0 < L; c0 += 64) {
        __syncthreads();
        for (int i = v; i < 64 * DK; i += 64) { const int s = i / DK, d = i % DK; const int t = dir ? L - 1 - (c0 + s) : c0 + s; const size_t tok = base + t;
            if (!GLA && lat) { sq[s][d] = RQ[(tok - TC) * 256 + h * 64 + d]; sk[s][d] = RK[(tok - TC) * 256 + h * 64 + d]; }
            else { sq[s][d] = bf2f(P[tok * 3072 + cq + d]); sk[s][d] = bf2f(P[tok * 3072 + ck_ + d]); }
            if (GLA) sa[s][d] = __expf(LG[tok * 256 + dir * 128 + h * DK + d]); }
        for (int i = v; i < 64 * 64; i += 64) { const int s = i >> 6, d = i & 63; const int t = dir ? L - 1 - (c0 + s) : c0 + s; sv[s][d] = bf2f(P[(size_t)(base + t) * 3072 + cvv + d]); }
        __syncthreads();
        for (int s = 0; s < 64; ++s) { const float vv = sv[s][v]; float o = 0.f;
#pragma unroll
            for (int d = 0; d < DK; ++d) { S[d] = (GLA ? sa[s][d] : gam) * S[d] + sk[s][d] * vv; o += sq[s][d] * S[d]; }
            const int t = dir ? L - 1 - (c0 + s) : c0 + s; OD[(size_t)(base + t) * 256 + h * 64 + v] = o; }
    }
    if (!lat) {
#pragma unroll
        for (int d = 0; d < DK; ++d) out_state[((((size_t)seq * 4 + l) * 2 + dir) * 4 + h) * DK * 64 + d * 64 + v] = S[d];
    }
}
__global__ void nv_finish(const bf16* P, bf16* O, const float* OFr, const float* OBr, const float* OFg, const float* OBg, const float* norm_g) {
    const int t = blockIdx.x, c = threadIdx.x, d = c & 63;
    { const float x = OFr[(size_t)t * 256 + c] + OBr[(size_t)t * 256 + c]; const float mu = wave_sum(x) * (1.f / 64.f); const float xc = x - mu; const float var = wave_sum(xc * xc) * (1.f / 64.f);
      const float g = bf2f(P[(size_t)t * 3072 + C_RG + c]); O[(size_t)t * 1024 + 512 + c] = (bf16)f2bf(xc * (1.0f / sqrtf(var + GN_EPS)) * siluf(g)); }
    { const float x = OFg[(size_t)t * 256 + c] + OBg[(size_t)t * 256 + c]; const float ms = wave_sum(x * x) * (1.f / 64.f);
      const float g = bf2f(P[(size_t)t * 3072 + C_AG + c]); O[(size_t)t * 1024 + 768 + c] = (bf16)f2bf(x * (1.0f / sqrtf(ms + RMS_EPS)) * norm_g[d] * siluf(g)); }
}
__global__ void __launch_bounds__(NTHR, 2) mega(Args a) {
    extern __shared__ __attribute__((aligned(16))) unsigned char lds_raw[];
    LAS unsigned char* lds = (LAS unsigned char*)lds_raw;
    unsigned char* ws = a.ws;
    const int G = gridDim.x;
    for (int ph = a.ph_lo; ph < a.ph_hi; ++ph) {
        if (ph == 0) phase_p0a(a, lds);
        else if (ph == 1) phase_p0b(a);
        else {
            const int l = (ph - 2) / 9, k = (ph - 2) % 9;
            if (k == 0) {
                pg8::Gemm g{(const pg8::bf16_t*)(ws + WS_H), (const pg8::bf16_t*)(ws + WS_W1 + l * W1_L), T, NP, D}; pg8::StaticOrder S; S.init(T, NP, G, (int)blockIdx.x);
                pg8::EpiG1 E{(pg8::bf16_t*)(ws + WS_P), (float*)(ws + WS_LG), a.out + O_CK, a.out + O_CV, a.in[I_GB], l};
                pg8::gemm_phase<pg8::EpiG1, pg8::StaticOrder, true, true>(lds + RING_OFF, g, S, E);
            } else if (k == 4 || k == 7) {
                pg8::Gemm g = (k == 4) ? pg8::Gemm{(const pg8::bf16_t*)(ws + WS_O), (const pg8::bf16_t*)(ws + WS_W2 + l * W2_L), T, D, D}
                                       : pg8::Gemm{(const pg8::bf16_t*)(ws + WS_U3), (const pg8::bf16_t*)(ws + WS_W4 + l * W4_L), T, D, DFF};
                pg8::StaticOrder S; S.init(T, D, G, (int)blockIdx.x);
                pg8::EpiF32 E{(float*)(ws + WS_Y), D};
                pg8::gemm_phase<pg8::EpiF32, pg8::StaticOrder, true, true>(lds + RING_OFF, g, S, E);
            } else if (k == 6) {
                pg8::Gemm g{(const pg8::bf16_t*)(ws + WS_H), (const pg8::bf16_t*)(ws + WS_W3 + l * W3_L), T, N3, D}; pg8::StaticOrder S; S.init(T, N3, G, (int)blockIdx.x);
                pg8::EpiG3 E{(pg8::bf16_t*)(ws + WS_U3)};
                pg8::gemm_phase<pg8::EpiG3, pg8::StaticOrder, true, true>(lds + RING_OFF, g, S, E);
            } else if (k == 5) phase_rowpass(a, l, 0);
            else if (k == 8) phase_rowpass(a, l, 1);
        }
        if (ph + 1 < a.ph_hi) { cg::this_grid().sync(); }
    }
}

extern "C" void kernel_launch(void* const* d_in, const int* in_sizes, int n_in, void* d_out, int out_size, void* d_ws, size_t ws_size, hipStream_t stream) {
    static int grid = 0;
    if (grid == 0) {
        if (n_in != N_IN || (size_t)out_size != O_END || ws_size < WS_END) { fprintf(stderr, "kernel_launch: unexpected shapes: n_in %d out %d ws %zu (need %zu)\n", n_in, out_size, ws_size, (size_t)WS_END); grid = -1; return; }
        int dev = 0, cus = 0, per_cu = 0;
        if (hipGetDevice(&dev) != hipSuccess || hipDeviceGetAttribute(&cus, hipDeviceAttributeMultiprocessorCount, dev) != hipSuccess) { grid = -1; return; }
        if (hipFuncSetAttribute((const void*)mega, hipFuncAttributeMaxDynamicSharedMemorySize, LDS_BYTES) != hipSuccess) { fprintf(stderr, "kernel_launch: hipFuncSetAttribute failed\n"); grid = -1; return; }
        if (hipOccupancyMaxActiveBlocksPerMultiprocessor(&per_cu, (const void*)mega, NTHR, LDS_BYTES) != hipSuccess || per_cu < 1) { fprintf(stderr, "kernel_launch: occupancy query says %d\n", per_cu); per_cu = 1; }
        (void)hipGetLastError();
        grid = cus;
    }
    if (grid < 0) return;
    Args a{};
    for (int i = 0; i < N_IN; ++i) a.in[i] = (const float*)d_in[i];
    a.out = (float*)d_out; a.ws = (unsigned char*)d_ws;
    unsigned char* ws = (unsigned char*)d_ws;
    auto run = [&](int lo, int hi) {
        a.ph_lo = lo; a.ph_hi = hi; a.coop = (hi - lo > 1);
        if (hi - lo > 1) { void* args[] = {&a}; hipError_t e = hipLaunchCooperativeKernel((const void*)mega, dim3(grid), dim3(NTHR), args, LDS_BYTES, stream); if (e != hipSuccess) fprintf(stderr, "coop launch failed: %s\n", hipGetErrorString(e)); }
        else hipLaunchKernelGGL(mega, dim3(grid), dim3(NTHR), LDS_BYTES, stream, a);
    };
    const bf16* P = (const bf16*)(ws + WS_P); bf16* O = (bf16*)(ws + WS_O); const float* LG = (const float*)(ws + WS_LG);
    float* OFr = (float*)(ws + WS_SCAN), *OBr = OFr + (size_t)T * 256, *OFg = OBr + (size_t)T * 256, *OBg = OFg + (size_t)T * 256, *RQ = OBg + (size_t)T * 256, *RK = RQ + (size_t)8192 * 256;
    const float* const* in = (const float* const*)d_in; float* out = (float*)d_out;
    run(0, 1); run(1, 2);
    for (int l = 0; l < DEPTH; ++l) {
        const int b = 2 + 9 * l;
        run(b, b + 1);
        hipLaunchKernelGGL(nv_rope, dim3(8192 * 128 / 256), dim3(256), 0, stream, P, RQ, RK);
        hipLaunchKernelGGL(nv_pool, dim3(T), dim3(256), 0, stream, P, O, in[I_POOLW] + (size_t)l * 4 * 64 * 64, in[I_POOLS] + l * 256);
        hipLaunchKernelGGL(nv_attn_ctx, dim3(TC * 4), dim3(64), 0, stream, P, O);
        hipLaunchKernelGGL(nv_attn_lat, dim3(8192 * 4), dim3(64), 0, stream, P, O, in[I_CK], in[I_CV], in[I_RPB], l);
        hipLaunchKernelGGL((nv_scan<64, false>), dim3(34 * 8), dim3(64), 0, stream, P, (const float*)RQ, (const float*)RK, LG, in[I_SR], in[I_RETL], OFr, OBr, out + O_SR, l);
        hipLaunchKernelGGL((nv_scan<32, true>), dim3(34 * 8), dim3(64), 0, stream, P, (const float*)RQ, (const float*)RK, LG, in[I_SG], in[I_RETL], OFg, OBg, out + O_SG, l);
        hipLaunchKernelGGL(nv_finish, dim3(T), dim3(256), 0, stream, P, O, (const float*)OFr, (const float*)OBr, (const float*)OFg, (const float*)OBg, in[I_GNG] + l * 64);
        run(b + 4, b + 5); run(b + 5, b + 6); run(b + 6, b + 7); run(b + 7, b + 8); run(b + 8, b + 9);
    }
}
```

```cpp
#include <hip/hip_runtime.h>
#include <hip/hip_cooperative_groups.h>
#include <cstdio>
#include <cstdint>
namespace cg = cooperative_groups;

constexpr int T = 16384, TC = 8192, D = 1024, NP = 3072, PIN = 2832, DFF = 2816, N3 = 5632, DEPTH = 4;
constexpr int C_VP = 0, C_NQ = 256, C_NK = 512, C_NV = 768, C_RQ = 1024, C_RK = 1280, C_RV = 1536, C_RG = 1792, C_AQ = 2048, C_AK = 2176, C_AV = 2304, C_AG = 2560;
constexpr float RMS_EPS = 1e-6f, GN_EPS = 1e-5f;
enum { I_XP = 0, I_XS, I_CK, I_CV, I_SR, I_SG, I_C, I_CCTX, I_WMOD, I_BMOD, I_GPM, I_GQM, I_GPF, I_GQF, I_WIN, I_WOUT, I_POOLW, I_POOLS, I_RPB, I_RETL, I_GUP, I_GB, I_GNG, I_WG, I_WU, I_WD, N_IN };
constexpr size_t O_Y = 0, O_CK = (size_t)T * D, O_CV = O_CK + 8388608, O_SR = O_CV + 8388608, O_SG = O_SR + 4194304, O_END = O_SG + 2097152;
constexpr size_t MiB = 1u << 20;
constexpr size_t WS_CTL = 0, CTL_ZERO_BYTES = 1 * MiB;
constexpr size_t WS_MOD = 1 * MiB;
constexpr size_t WS_ROPE = WS_MOD + 512 * 1024;
constexpr size_t WS_W1 = 2 * MiB, W1_L = (size_t)NP * D * 2;
constexpr size_t WS_W2 = WS_W1 + 4 * W1_L, W2_L = (size_t)D * D * 2;
constexpr size_t WS_W3 = WS_W2 + 4 * W2_L, W3_L = (size_t)N3 * D * 2;
constexpr size_t WS_W4 = WS_W3 + 4 * W3_L, W4_L = (size_t)D * DFF * 2;
constexpr size_t WS_H = WS_W4 + 4 * W4_L;
constexpr size_t WS_O = WS_H + (size_t)T * D * 2;
constexpr size_t WS_BIG = WS_O + (size_t)T * D * 2;
constexpr size_t WS_P = WS_BIG;
constexpr size_t WS_U3 = WS_BIG;
constexpr size_t WS_Y = WS_BIG + (size_t)T * NP * 2;
constexpr size_t WS_LG = WS_Y;
constexpr size_t WS_SCAN = WS_LG + (size_t)T * 256 * 4;
constexpr size_t WS_UR = WS_SCAN, WS_SR = WS_SCAN + 16 * MiB, WS_UG = WS_SCAN + 32 * MiB, WS_SG = WS_SCAN + 48 * MiB, WS_GG = WS_SCAN + 64 * MiB;
constexpr size_t WS_NAIVE = WS_SCAN + 66 * MiB;
constexpr size_t WS_END = WS_NAIVE + 32 * MiB;
namespace pg8 {
#define PG8_LAS __attribute__((address_space(3)))
typedef unsigned short bf16_t;
typedef short bf16x8 __attribute__((ext_vector_type(8)));
typedef float f32x4 __attribute__((ext_vector_type(4)));
typedef unsigned u32x4 __attribute__((ext_vector_type(4)));
constexpr int BM = 256, BK = 64, HALF = 128, HTB = HALF * BK * 2  , STAGE_BYTES = 8 * HTB, NXCD = 8, WGM = 8;

__host__ __device__ __forceinline__ int lds_byte(int r, int c) { const int st = (r >> 4) * 2 + (c >> 5), rr = r & 15, cc = c & 31, ob = rr * 64 + cc * 2; return st * 1024 + (ob ^ (((ob >> 9) & 1) << 5)); }
__host__ __device__ __forceinline__ void stage_rc(int b, int& R, int& C) { const int st = b / 1024, sb = b % 1024, swz = sb ^ (((sb >> 9) & 1) << 5); R = (st >> 1) * 16 + swz / 64; C = (st & 1) * 32 + (swz % 64) / 2; }
__host__ __device__ __forceinline__ int perm32(int rho) { const int n = rho >> 4, i = rho & 15; return 8 * (i >> 2) + 4 * n + (i & 3); }

struct Unit { int pm, pn; };
struct Gemm { const bf16_t* A; const bf16_t* Bt; int M, N, K; };

struct StaticOrder {
    int nM, nN, nwg, G, c;
    __host__ __device__ void init(int M, int N, int G_, int c_) { nM = M / BM; nN = N / BM; nwg = nM * nN; G = G_; c = c_; }
    __host__ __device__ bool next(int i, Unit& u) const {
        const long L = (long)i * G + c; if (L >= nwg) return false;
        int wgid = (int)L; { const int q = nwg / NXCD, r = nwg % NXCD, xcd = wgid % NXCD, off = wgid / NXCD; wgid = (xcd < r ? xcd * (q + 1) : r * (q + 1) + (xcd - r) * q) + off; }
        const int nig = WGM * nN, gid = wgid / nig, fm = gid * WGM, gsz = (nM - fm) < WGM ? (nM - fm) : WGM;
        u.pm = fm + ((wgid % nig) % gsz); u.pn = (wgid % nig) / gsz; return true;
    }
    __device__ __forceinline__ void a_ready(const Unit&) const {}
    __device__ __forceinline__ void done(const Unit&) const {}
};

__device__ __forceinline__ unsigned cvt_pk_bf16(float lo, float hi) { unsigned r; asm volatile("v_cvt_pk_bf16_f32 %0, %1, %2" : "=v"(r) : "v"(lo), "v"(hi)); return r; }
__device__ __forceinline__ float siluf(float x) { return x / (1.0f + __expf(-x)); }
__device__ __forceinline__ float logsigf(float z) { return fminf(z, 0.f) - log1pf(__expf(-fabsf(z))); }
struct EpiG1 {
    static constexpr bool PERM = true, AFTER_DRAIN = false;
    bf16_t* P; float* LG; float* outK; float* outV; int layer;
    __device__ __forceinline__ void operator()(const f32x4 (&acc)[2][2][4][2], const Unit& u, int wr, int wc, int fr, int fq) const {
        const int lrow = wr * 64 + fr, cl = wc * 32 + 8 * fq;
        if (u.pn < 11) {
            bf16_t* rowp = P + (size_t)(u.pm * BM + lrow) * 3072 + u.pn * BM + cl;
#pragma unroll
            for (int ai = 0; ai < 2; ++ai)
#pragma unroll
                for (int m = 0; m < 4; ++m) {
#pragma unroll
                    for (int bj = 0; bj < 2; ++bj) { const f32x4 v0 = acc[ai][bj][m][0], v1 = acc[ai][bj][m][1];
                        u32x4 w; w.x = cvt_pk_bf16(v0[0], v0[1]); w.y = cvt_pk_bf16(v0[2], v0[3]); w.z = cvt_pk_bf16(v1[0], v1[1]); w.w = cvt_pk_bf16(v1[2], v1[3]);
                        *(u32x4*)(rowp + (size_t)(ai * HALF + m * 16) * 3072 + bj * HALF) = w; }
                    asm volatile("" ::: "memory"); }
        }
        float* f32dst = nullptr;
        if (u.pn == 11) f32dst = LG + (size_t)u.pm * (BM * 256);
        else if ((u.pn == 2 || u.pn == 3) && u.pm < 32) f32dst = (u.pn == 2 ? outK : outV) + (size_t)(u.pm * 4 + layer) * (256 * 256);
        if (f32dst) {
            float* rowp = f32dst + (size_t)lrow * 256 + cl;
#pragma unroll
            for (int ai = 0; ai < 2; ++ai)
#pragma unroll
                for (int m = 0; m < 4; ++m) {
#pragma unroll
                    for (int bj = 0; bj < 2; ++bj) { *(f32x4*)(rowp + (ai * HALF + m * 16) * 256 + bj * HALF) = acc[ai][bj][m][0]; *(f32x4*)(rowp + (ai * HALF + m * 16) * 256 + bj * HALF + 4) = acc[ai][bj][m][1]; }
                    asm volatile("" ::: "memory"); }
        }
    }
};
struct EpiF32 {
    static constexpr bool PERM = false, AFTER_DRAIN = false;
    float* C; int ldc;
    __device__ __forceinline__ void operator()(const f32x4 (&acc)[2][2][4][2], const Unit& u, int wr, int wc, int fr, int fq) const {
        const int row0 = u.pm * BM + wr * 64 + fr, col0 = u.pn * BM + wc * 32 + 4 * fq;
#pragma unroll
        for (int ai = 0; ai < 2; ++ai)
#pragma unroll
            for (int m = 0; m < 4; ++m) { float* rowp = C + (size_t)(row0 + ai * HALF + m * 16) * ldc + col0;
#pragma unroll
                for (int bj = 0; bj < 2; ++bj)
#pragma unroll
                    for (int n = 0; n < 2; ++n) *(f32x4*)(rowp + bj * HALF + n * 16) = acc[ai][bj][m][n]; }
    }
};
struct EpiG3 {
    static constexpr bool PERM = true, AFTER_DRAIN = false;
    bf16_t* U;
    __device__ __forceinline__ void operator()(const f32x4 (&acc)[2][2][4][2], const Unit& u, int wr, int wc, int fr, int fq) const {
        const int row0 = u.pm * BM + wr * 64 + fr, col0 = u.pn * HALF + wc * 32 + 8 * fq;
#pragma unroll
        for (int ai = 0; ai < 2; ++ai)
#pragma unroll
            for (int m = 0; m < 4; ++m) { f32x4 v0, v1;
#pragma unroll
                for (int j = 0; j < 4; ++j) { v0[j] = siluf(acc[ai][0][m][0][j]) * acc[ai][1][m][0][j]; v1[j] = siluf(acc[ai][0][m][1][j]) * acc[ai][1][m][1][j]; }
                u32x4 w; w.x = cvt_pk_bf16(v0[0], v0[1]); w.y = cvt_pk_bf16(v0[2], v0[3]); w.z = cvt_pk_bf16(v1[0], v1[1]); w.w = cvt_pk_bf16(v1[2], v1[3]);
                *(u32x4*)(U + (size_t)(row0 + ai * HALF + m * 16) * 2816 + col0) = w; }
    }
};
template <class Epi, class Sched, bool ALIGN_EPI = false, bool SP2 = false>
__device__ __forceinline__ void gemm_phase(PG8_LAS unsigned char* lds, const Gemm g, const Sched& S, const Epi& E) {
    int tid_ = threadIdx.x; asm volatile("" : "+v"(tid_)); const int tid = tid_, wid = __builtin_amdgcn_readfirstlane(tid >> 6), lane = tid & 63, wr = wid >> 2, wc = wid & 3, fr = lane & 15, fq = lane >> 4;
    const int K = g.K, nt = K / BK;
    unsigned voffA[2], voffB[2];
#pragma unroll
    for (int i = 0; i < 2; ++i) { int R, C; stage_rc(tid * 16 + i * 8192, R, C); const int Rb = Epi::PERM ? ((R & ~31) + perm32(R & 31)) : R;
        voffA[i] = (unsigned)(R * K + C) * 2u; voffB[i] = (unsigned)(Rb * K + C) * 2u; }
    const size_t kstep = (size_t)(BK * 2);
    const size_t hstep = (size_t)HALF * K * 2;
    const size_t tstep = 2 * hstep;
    const unsigned ldsw = (unsigned)wid * 1024u;
    const int aoff = lds_byte(wr * 64 + fr, fq * 8), boff = lds_byte(wc * 32 + fr, fq * 8);
#define PG8_SA(b, h) (((b) * 2 + (h)) * HTB)
#define PG8_SB(b, h) ((4 + (b) * 2 + (h)) * HTB)
#define PG8_STAGE(bufoff, gbase, voff) do { _Pragma("unroll") for (int _i = 0; _i < 2; ++_i) \
        __builtin_amdgcn_global_load_lds((const unsigned*)((const char*)(gbase) + (voff)[_i]), (PG8_LAS unsigned*)(lds + (bufoff) + ldsw + _i * 8192), 16, 0, 0); } while (0)
#define PG8_LDA(dst, b, h) do { _Pragma("unroll") for (int m = 0; m < 4; ++m) _Pragma("unroll") for (int k = 0; k < 2; ++k) dst[m][k] = *(const PG8_LAS bf16x8*)(lds + PG8_SA(b, h) + aoff + m * 2048 + k * 1024); } while (0)
#define PG8_LDB(dst, b, h) do { _Pragma("unroll") for (int n = 0; n < 2; ++n) _Pragma("unroll") for (int k = 0; k < 2; ++k) dst[n][k] = *(const PG8_LAS bf16x8*)(lds + PG8_SB(b, h) + boff + n * 2048 + k * 1024); } while (0)
#define PG8_MMA(ai, bj, At, Bt) do { __builtin_amdgcn_s_setprio(1); _Pragma("unroll") for (int m = 0; m < 4; ++m) _Pragma("unroll") for (int n = 0; n < 2; ++n) _Pragma("unroll") for (int k = 0; k < 2; ++k) \
        acc[ai][bj][m][n] = __builtin_amdgcn_mfma_f32_16x16x32_bf16(Bt[n][k], At[m][k], acc[ai][bj][m][n], 0, 0, 0); __builtin_amdgcn_s_setprio(0); } while (0)
#define PG8_WAIT_V(n) asm volatile("s_waitcnt vmcnt(" #n ")" ::: "memory")
#define PG8_WAIT_L(n) asm volatile("s_waitcnt lgkmcnt(" #n ")" ::: "memory")
#define PG8_BAR __builtin_amdgcn_s_barrier()
#define PG8_SCHED __builtin_amdgcn_sched_barrier(0)
    Unit cur, nxt; int ui = 0;
    if (!S.next(0, cur)) return;
    f32x4 acc[2][2][4][2];
#pragma unroll
    for (int a = 0; a < 2; ++a)
#pragma unroll
        for (int b = 0; b < 2; ++b)
#pragma unroll
            for (int m = 0; m < 4; ++m)
#pragma unroll
                for (int n = 0; n < 2; ++n) acc[a][b][m][n] = (f32x4){0.f, 0.f, 0.f, 0.f};
    bf16x8 At[4][2], B0[2][2], B1[2][2];
    const char* cA = (const char*)g.A + (size_t)cur.pm * tstep; const char* cB = (const char*)g.Bt + (size_t)cur.pn * tstep;
    S.a_ready(cur);
    if constexpr (SP2) {
        PG8_STAGE(PG8_SB(0, 0), cB, voffB); PG8_STAGE(PG8_SB(0, 1), cB + hstep, voffB); PG8_STAGE(PG8_SA(0, 0), cA, voffA); PG8_STAGE(PG8_SA(0, 1), cA + hstep, voffA);
        if (wr == 1) PG8_BAR;
        PG8_WAIT_V(2); PG8_BAR;
        PG8_STAGE(PG8_SB(1, 0), cB + kstep, voffB); PG8_STAGE(PG8_SA(1, 0), cA + kstep, voffA); PG8_STAGE(PG8_SB(1, 1), cB + hstep + kstep, voffB);
        PG8_WAIT_V(6); PG8_BAR;
    } else {
        PG8_STAGE(PG8_SB(0, 0), cB, voffB); PG8_STAGE(PG8_SA(0, 0), cA, voffA); PG8_STAGE(PG8_SB(0, 1), cB + hstep, voffB); PG8_STAGE(PG8_SA(0, 1), cA + hstep, voffA);
        if (wr == 1) PG8_BAR;
        PG8_WAIT_V(4); PG8_BAR;
        PG8_STAGE(PG8_SB(1, 0), cB + kstep, voffB); PG8_STAGE(PG8_SA(1, 0), cA + kstep, voffA); PG8_STAGE(PG8_SB(1, 1), cB + hstep + kstep, voffB);
        PG8_WAIT_V(6); PG8_BAR;
    }
    for (;;) {
        const bool has_next = S.next(ui + 1, nxt);
        const char* nA = has_next ? (const char*)g.A + (size_t)nxt.pm * tstep : cA; const char* nB = has_next ? (const char*)g.Bt + (size_t)nxt.pn * tstep : cB;
        for (int t = 0; t < nt; t += 2) {
            const bool last = (t == nt - 2);
            const char* a1 = cA + (size_t)(t + 1) * kstep;
            const char* a2 = last ? nA : cA + (size_t)(t + 2) * kstep; const char* b2 = last ? nB : cB + (size_t)(t + 2) * kstep;
            const char* a3 = a2 + kstep; const char* b3 = b2 + kstep;
            if (last && has_next) S.a_ready(nxt);
            if constexpr (SP2) {
            PG8_LDB(B0, 0, 0); PG8_LDB(B1, 0, 1); PG8_SCHED; PG8_LDA(At, 0, 0); PG8_STAGE(PG8_SA(1, 1), a1 + hstep, voffA);
            PG8_WAIT_V(8); PG8_WAIT_L(0); PG8_BAR; PG8_MMA(0, 0, At, B0); PG8_MMA(0, 1, At, B1); PG8_BAR; PG8_SCHED;
            PG8_LDA(At, 0, 1); PG8_STAGE(PG8_SB(0, 0), b2, voffB); PG8_STAGE(PG8_SB(0, 1), b2 + hstep, voffB); PG8_STAGE(PG8_SA(0, 0), a2, voffA);
            PG8_WAIT_V(8); PG8_WAIT_L(0); PG8_BAR; PG8_MMA(1, 0, At, B0); PG8_MMA(1, 1, At, B1); PG8_BAR; PG8_SCHED;
            PG8_LDB(B0, 1, 0); PG8_LDB(B1, 1, 1); PG8_SCHED; PG8_LDA(At, 1, 0); PG8_STAGE(PG8_SA(0, 1), a2 + hstep, voffA);
            PG8_WAIT_V(8); PG8_WAIT_L(0); PG8_BAR; PG8_MMA(0, 0, At, B0); PG8_MMA(0, 1, At, B1); PG8_BAR; PG8_SCHED;
            PG8_LDA(At, 1, 1); PG8_STAGE(PG8_SB(1, 0), b3, voffB); PG8_STAGE(PG8_SB(1, 1), b3 + hstep, voffB); PG8_STAGE(PG8_SA(1, 0), a3, voffA);
            PG8_WAIT_V(8); PG8_WAIT_L(0); PG8_BAR; PG8_MMA(1, 0, At, B0); PG8_MMA(1, 1, At, B1); PG8_BAR; PG8_SCHED;
            } else {
            PG8_LDB(B0, 0, 0); PG8_SCHED; PG8_LDA(At, 0, 0); PG8_STAGE(PG8_SA(1, 1), a1 + hstep, voffA);
            PG8_WAIT_L(8); PG8_BAR; PG8_WAIT_L(0); PG8_MMA(0, 0, At, B0); PG8_BAR; PG8_SCHED;
            PG8_LDB(B1, 0, 1); PG8_STAGE(PG8_SB(0, 0), b2, voffB);
            PG8_BAR; PG8_WAIT_L(0); PG8_MMA(0, 1, At, B1); PG8_BAR;
            PG8_LDA(At, 0, 1); PG8_STAGE(PG8_SA(0, 0), a2, voffA);
            PG8_BAR; PG8_WAIT_L(0); PG8_MMA(1, 0, At, B0); PG8_BAR; PG8_SCHED;
            PG8_STAGE(PG8_SB(0, 1), b2 + hstep, voffB);
            PG8_WAIT_V(6); PG8_BAR; PG8_MMA(1, 1, At, B1); PG8_BAR;
            PG8_LDB(B0, 1, 0); PG8_SCHED; PG8_LDA(At, 1, 0); PG8_STAGE(PG8_SA(0, 1), a2 + hstep, voffA);
            PG8_WAIT_L(8); PG8_BAR; PG8_WAIT_L(0); PG8_MMA(0, 0, At, B0); PG8_BAR; PG8_SCHED;
            PG8_LDB(B1, 1, 1); PG8_STAGE(PG8_SB(1, 0), b3, voffB);
            PG8_BAR; PG8_WAIT_L(0); PG8_MMA(0, 1, At, B1); PG8_BAR;
            PG8_LDA(At, 1, 1); PG8_STAGE(PG8_SA(1, 0), a3, voffA);
            PG8_BAR; PG8_WAIT_L(0); PG8_MMA(1, 0, At, B0); PG8_BAR; PG8_SCHED;
            PG8_STAGE(PG8_SB(1, 1), b3 + hstep, voffB);
            PG8_WAIT_V(6); PG8_BAR; PG8_MMA(1, 1, At, B1); PG8_BAR;
            }
        }
        if constexpr (ALIGN_EPI) { if (wr == 0) PG8_BAR; }
        if constexpr (!Epi::AFTER_DRAIN) { E(acc, cur, wr, wc, fr, fq); S.done(cur); }
        if (!has_next) break;
#pragma unroll
        for (int a = 0; a < 2; ++a)
#pragma unroll
            for (int b = 0; b < 2; ++b)
#pragma unroll
                for (int m = 0; m < 4; ++m)
#pragma unroll
                    for (int n = 0; n < 2; ++n) acc[a][b][m][n] = (f32x4){0.f, 0.f, 0.f, 0.f};
        cur = nxt; cA = nA; cB = nB; ++ui;
        if constexpr (ALIGN_EPI) { if (wr == 1) PG8_BAR; }
    }
    PG8_WAIT_V(0);
    if constexpr (!ALIGN_EPI) { if (wr == 0) PG8_BAR; }
    PG8_BAR;
    if constexpr (Epi::AFTER_DRAIN) { E.fused(acc, cur, wr, wc, fr, fq, lds, wid, lane); S.done(cur); }
#undef PG8_SA
#undef PG8_SB
#undef PG8_STAGE
#undef PG8_LDA
#undef PG8_LDB
#undef PG8_MMA
#undef PG8_WAIT_V
#undef PG8_WAIT_L
#undef PG8_BAR
#undef PG8_SCHED
}
}
constexpr int NWAVES = 8, NTHR = 512;
constexpr int RING_OFF = 0, RING_BYTES = 131072;
constexpr int LDSCTL_OFF = RING_BYTES, MISC_OFF = LDSCTL_OFF + 320;
constexpr int LDS_BYTES = 147456;
constexpr int CW_BAR = 4096;
#define GAS __attribute__((address_space(1)))
#define LAS __attribute__((address_space(3)))
typedef unsigned short bf16;
typedef unsigned v4u __attribute__((ext_vector_type(4)));
typedef unsigned v2u __attribute__((ext_vector_type(2)));
typedef float f32x4 __attribute__((ext_vector_type(4)));
typedef short bf16x8 __attribute__((ext_vector_type(8)));
#define LDS_WAIT() asm volatile("s_waitcnt lgkmcnt(0)" ::: "memory")
#define VM_WAIT() asm volatile("s_waitcnt vmcnt(0)" ::: "memory")
__device__ __forceinline__ unsigned f2bf(float f) { unsigned u = __builtin_bit_cast(unsigned, f); return (u + 0x7fffu + ((u >> 16) & 1u)) >> 16; }
__device__ __forceinline__ unsigned pk2(float lo, float hi) { return f2bf(lo) | (f2bf(hi) << 16); }
__device__ __forceinline__ float bf2f(bf16 b) { return __builtin_bit_cast(float, (unsigned)b << 16); }
__device__ __forceinline__ float wave_sum(float v) {
#pragma unroll
    for (int o = 1; o < 64; o <<= 1) v += __shfl_xor(v, o);
    return v;
}
__device__ __forceinline__ float siluf(float x) { return x / (1.0f + __expf(-x)); }
__device__ __forceinline__ int opaque_tid() { int t = threadIdx.x; asm volatile("" : "+v"(t)); return t; }

struct Args { const float* in[N_IN]; float* out; unsigned char* ws; int ph_lo, ph_hi, coop, mask; };

constexpr int NPH = 2 + 9 * DEPTH;
typedef const Args __attribute__((address_space(4)))* KArgs;
__device__ __forceinline__ KArgs kargs() { const void __attribute__((address_space(4)))* p = (const void __attribute__((address_space(4)))*)__builtin_amdgcn_kernarg_segment_ptr(); asm volatile("" : "+s"(p)); return (KArgs)p; }

__device__ __forceinline__ void p0_transpose_item(const float* W, int ldw, int k0, int n_src0, bf16* WT, int Kdst, int dst_row0, float scale, LAS float* scr, int lane) {
#pragma unroll 8
    for (int i = 0; i < 32; ++i) { const int kk = 2 * i + (lane >> 5); scr[kk * 33 + (lane & 31)] = W[(size_t)(k0 + kk) * ldw + n_src0 + (lane & 31)]; }
    LDS_WAIT(); asm volatile("" ::: "memory");
    const int c = lane & 7;
#pragma unroll
    for (int j = 0; j < 4; ++j) { const int n = (lane >> 3) + 8 * j; const LAS float* s = scr + (8 * c) * 33 + n;
        v4u o; o.x = pk2(s[0 * 33] * scale, s[1 * 33] * scale); o.y = pk2(s[2 * 33] * scale, s[3 * 33] * scale); o.z = pk2(s[4 * 33] * scale, s[5 * 33] * scale); o.w = pk2(s[6 * 33] * scale, s[7 * 33] * scale);
        *(GAS v4u*)(WT + (size_t)(dst_row0 + n) * Kdst + k0 + 8 * c) = o; }
    LDS_WAIT(); asm volatile("" ::: "memory");
}

__device__ __forceinline__ void phase_p0a(KArgs a, LAS unsigned char* lds) {
    const int tid = opaque_tid(), lane = tid & 63, wave = tid >> 6;
    const int G = gridDim.x, gw = blockIdx.x * NWAVES + wave, NGW = G * NWAVES;
    unsigned char* ws = a->ws;
    LAS float* scr = (LAS float*)(lds + wave * 16384);
    constexpr int IT_IN = 16 * 88, IT_OUT = 16 * 32, IT_G = 16 * 88, IT_D = 44 * 32, IT_L = IT_IN + IT_OUT + 2 * IT_G + IT_D;
    for (int it = gw; it < DEPTH * IT_L; it += NGW) {
        const int l = it / IT_L; int r = it % IT_L;
        if (r < IT_IN) { const int kb = r / 88, nb = r % 88, n0 = nb * 32;
            const float sc = (n0 >= C_NQ && n0 < C_NK) ? 0.125f : (n0 >= C_RQ && n0 < C_RK) ? 0.125f : (n0 >= C_AQ && n0 < C_AK) ? 0.17677669529663687f : 1.0f;
            p0_transpose_item(a->in[I_WIN] + (size_t)l * D * PIN, PIN, kb * 64, n0, (bf16*)(ws + WS_W1 + l * W1_L), D, n0, sc, scr, lane); continue; }
        r -= IT_IN;
        if (r < IT_OUT) { const int kb = r / 32, nb = r % 32;
            p0_transpose_item(a->in[I_WOUT] + (size_t)l * D * D, D, kb * 64, nb * 32, (bf16*)(ws + WS_W2 + l * W2_L), D, nb * 32, 1.0f, scr, lane); continue; }
        r -= IT_OUT;
        if (r < 2 * IT_G) { const int up = r >= IT_G; if (up) r -= IT_G; const int kb = r / 88, nb = r % 88, n0 = nb * 32;
            p0_transpose_item((up ? a->in[I_WU] : a->in[I_WG]) + (size_t)l * D * DFF, DFF, kb * 64, n0, (bf16*)(ws + WS_W3 + l * W3_L), D, (n0 >> 7) * 256 + (up ? 128 : 0) + (n0 & 127), 1.0f, scr, lane); continue; }
        r -= 2 * IT_G;
        { const int kb = r / 32, nb = r % 32;
            p0_transpose_item(a->in[I_WD] + (size_t)l * DFF * D, D, kb * 64, nb * 32, (bf16*)(ws + WS_W4 + l * W4_L), DFF, nb * 32, 1.0f, scr, lane); }
    }
    for (int i = blockIdx.x * NTHR + tid; i < DEPTH * 256 * D; i += G * NTHR) {
        const int k = i & (D - 1), dj = (i >> 10) & 255, l = i >> 18;
        const float* wr = a->in[I_WIN] + ((size_t)l * D + k) * PIN + 2816; const float* gu = a->in[I_GUP] + (size_t)l * 2 * 16 * 128 + (dj >> 7) * 16 * 128 + (dj & 127);
        float s = 0.f;
#pragma unroll
        for (int r = 0; r < 16; ++r) s += wr[r] * gu[r * 128];
        ((bf16*)(ws + WS_W1 + l * W1_L))[(size_t)(2816 + dj) * D + k] = (bf16)f2bf(s);
    }
    for (int i = blockIdx.x * NTHR + tid; i < 1024; i += G * NTHR) { const int pos = i >> 4, j = i & 15; const float ang = (float)pos * powf(10000.0f, -(float)j / 16.0f); ((float2*)(ws + WS_ROPE))[i] = make_float2(cosf(ang), sinf(ang)); }
    __syncthreads();
    LAS float* sc = (LAS float*)lds;
    LAS float* red = (LAS float*)(lds + 16384);
    for (int i = tid; i < 3 * D; i += NTHR) { const int v = i >> 10, k = i & (D - 1); const float x = v == 0 ? a->in[I_CCTX][k] : a->in[I_C][(v - 1) * D + k]; sc[i] = siluf(x); }
    __syncthreads();
    float* MOD = (float*)(ws + WS_MOD);
    for (int it = blockIdx.x; it < DEPTH * 96; it += G) {
        const int l = it / 96, n0 = (it % 96) * 64;
        const float* w = a->in[I_WMOD] + (size_t)l * D * 6144 + (size_t)(wave * 128) * 6144 + n0 + lane;
        float a0 = 0.f, a1 = 0.f, a2 = 0.f;
#pragma unroll 8
        for (int k = 0; k < 128; ++k) { const float x = w[(size_t)k * 6144]; const int kk = wave * 128 + k; a0 += sc[kk] * x; a1 += sc[D + kk] * x; a2 += sc[2 * D + kk] * x; }
        red[(wave * 3 + 0) * 64 + lane] = a0; red[(wave * 3 + 1) * 64 + lane] = a1; red[(wave * 3 + 2) * 64 + lane] = a2;
        __syncthreads();
        if (tid < 192) { const int v = tid >> 6; float s = 0.f;
#pragma unroll
            for (int w8 = 0; w8 < 8; ++w8) s += red[(w8 * 3 + v) * 64 + lane];
            MOD[((size_t)l * 3 + v) * 6144 + n0 + lane] = s + a->in[I_BMOD][l * 6144 + n0 + lane]; }
        __syncthreads();
    }
}

__device__ __forceinline__ const float* mod_row(KArgs a, int l, int row) { const int mv = row < TC ? 0 : 1 + ((row - TC) >> 12); return (const float*)(a->ws + WS_MOD) + ((size_t)l * 3 + mv) * 6144; }
__device__ __forceinline__ const float* xin_row(KArgs a, int row) { return row < TC ? a->in[I_XP] + (size_t)row * D : a->in[I_XS] + (size_t)(row - TC) * D; }
__device__ __forceinline__ void phase_p0b(KArgs a) {
    const int tid = opaque_tid(), lane = tid & 63, wave = tid >> 6;
    const int gw = blockIdx.x * NWAVES + wave, NGW = gridDim.x * NWAVES;
    bf16* H = (bf16*)(a->ws + WS_H);
    for (int row = gw; row < T; row += NGW) {
        const float* mod = mod_row(a, 0, row);
        const f32x4* xr = (const f32x4*)xin_row(a, row) + lane;
        f32x4 v[4]; float s = 0.f;
#pragma unroll
        for (int j = 0; j < 4; ++j) { v[j] = xr[64 * j]; s += (v[j].x * v[j].x + v[j].y * v[j].y) + (v[j].z * v[j].z + v[j].w * v[j].w); }
        const float rstd = 1.0f / sqrtf(wave_sum(s) * (1.f / D) + RMS_EPS);
        unsigned long long* o8 = (unsigned long long*)(H + (size_t)row * D) + lane;
#pragma unroll
        for (int j = 0; j < 4; ++j) { const int c = 4 * lane + 256 * j;
            const f32x4 g = *(const f32x4*)(a->in[I_GPM] + c), sh = *(const f32x4*)(mod + c), scl = *(const f32x4*)(mod + D + c);
            const f32x4 h = v[j] * rstd * g * (scl + 1.0f) + sh;
            o8[64 * j] = (unsigned long long)pk2(h.x, h.y) | ((unsigned long long)pk2(h.z, h.w) << 32); }
    }
}
__device__ __forceinline__ void phase_rowpass(KArgs a, int l, int which) {
    const int tid = opaque_tid(), lane = tid & 63, wave = tid >> 6;
    const int gw = blockIdx.x * NWAVES + wave, NGW = gridDim.x * NWAVES;
    bf16* H = (bf16*)(a->ws + WS_H); const float* Y = (const float*)(a->ws + WS_Y);
    const float* gpost = (which ? a->in[I_GQF] : a->in[I_GQM]) + l * D;
    const bool need_h = (which == 0) || (l + 1 < DEPTH);
    const float* gpre = which == 0 ? a->in[I_GPF] + l * D : a->in[I_GPM] + (l + 1 < DEPTH ? l + 1 : l) * D;
    for (int row = gw; row < T; row += NGW) {
        const float* mod = mod_row(a, l, row);
        const float* modn = which == 0 ? mod : mod_row(a, l + 1 < DEPTH ? l + 1 : l, row);
        const f32x4* yr = (const f32x4*)(Y + (size_t)row * D) + lane;
        const f32x4* xr = (l == 0 && which == 0) ? (const f32x4*)xin_row(a, row) + lane : (const f32x4*)(a->out + (size_t)row * D) + lane;
        f32x4 y[4], x[4]; float s = 0.f;
#pragma unroll
        for (int j = 0; j < 4; ++j) { y[j] = yr[64 * j]; x[j] = xr[64 * j]; s += (y[j].x * y[j].x + y[j].y * y[j].y) + (y[j].z * y[j].z + y[j].w * y[j].w); }
        const float rstd = 1.0f / sqrtf(wave_sum(s) * (1.f / D) + RMS_EPS);
        float s2 = 0.f;
        f32x4* xo = (f32x4*)(a->out + (size_t)row * D) + lane;
#pragma unroll
        for (int j = 0; j < 4; ++j) { const int c = 4 * lane + 256 * j;
            const f32x4 g = *(const f32x4*)(gpost + c), gt = *(const f32x4*)(mod + (which ? 5 : 2) * D + c);
            x[j] = x[j] + gt * (y[j] * rstd * g);
            xo[64 * j] = x[j];
            s2 += (x[j].x * x[j].x + x[j].y * x[j].y) + (x[j].z * x[j].z + x[j].w * x[j].w); }
        if (need_h) {
            const float rstd2 = 1.0f / sqrtf(wave_sum(s2) * (1.f / D) + RMS_EPS);
            unsigned long long* o8 = (unsigned long long*)(H + (size_t)row * D) + lane;
#pragma unroll
            for (int j = 0; j < 4; ++j) { const int c = 4 * lane + 256 * j;
                const f32x4 g = *(const f32x4*)(gpre + c), sh = *(const f32x4*)(modn + (which == 0 ? 3 : 0) * D + c), scl = *(const f32x4*)(modn + (which == 0 ? 4 : 1) * D + c);
                const f32x4 h = x[j] * rstd2 * g * (scl + 1.0f) + sh;
                o8[64 * j] = (unsigned long long)pk2(h.x, h.y) | ((unsigned long long)pk2(h.z, h.w) << 32); }
        }
    }
}
#define XB_TMO      128
#define XB_XCNT(j)  (256  + 64 * (j))
#define XB_XSUB(j)  (1280 + 64 * (j))
#define XB_XGEN(j)  (2304 + 64 * (j))
#define XB_TOP      3328
#define XB_TOPGEN   3392
#define XCD_BAR_WORDS 3456
#define XB_SPIN_CAP (1u << 18)

__device__ __forceinline__ unsigned xb_ld(unsigned* p)              { return __hip_atomic_load(p, __ATOMIC_RELAXED, __HIP_MEMORY_SCOPE_AGENT); }
__device__ __forceinline__ unsigned xb_add(unsigned* p, unsigned v) { return __hip_atomic_fetch_add(p, v, __ATOMIC_RELAXED, __HIP_MEMORY_SCOPE_AGENT); }
__device__ __forceinline__ unsigned xb_xcc_id() { return (unsigned)__builtin_amdgcn_s_getreg((3 << 11) | 20) & 0xFu; }
#define XB_SPIN(cond, bar) do { unsigned _sp = 0; while (cond) { __builtin_amdgcn_s_sleep(1); \
    if ((++_sp & 255u) == 0u) { if (xb_ld(&(bar)[XB_TMO])) break; if (_sp > XB_SPIN_CAP) { atomicAdd(&(bar)[XB_TMO], 1u); break; } } } } while (0)

struct XcdBarrier {
    unsigned* bar; unsigned x;
    volatile LAS unsigned* st;
};

__device__ __forceinline__ XcdBarrier xcd_barrier_post(unsigned* bar, volatile LAS unsigned* st) {
    XcdBarrier b; b.bar = bar; b.x = xb_xcc_id(); b.st = st;
    if (threadIdx.x == 0) (void)xb_add(&bar[XB_XCNT(b.x)], 1u);
    return b;
}
__device__ __forceinline__ void xcd_barrier_complete(unsigned* bar, unsigned x, unsigned& nloc, unsigned& nx) {
    const unsigned G = gridDim.x * gridDim.y * gridDim.z;
    unsigned sum, cnt, mine, sp = 0u;
    for (;;) {
        sum = 0u; cnt = 0u; mine = 0u;
#pragma unroll
        for (unsigned j = 0; j < 16; ++j) { const unsigned c = xb_ld(&bar[XB_XCNT(j)]); sum += c; cnt += (c > 0u) ? 1u : 0u; mine = (j == x) ? c : mine; }
        if (sum == G) break;
        __builtin_amdgcn_s_sleep(1);
        if ((++sp & 255u) == 0u) { if (xb_ld(&bar[XB_TMO])) break; if (sp > XB_SPIN_CAP) { atomicAdd(&bar[XB_TMO], 1u); break; } }
    }
    nloc = mine > 0u ? mine : 1u; nx = cnt > 0u ? cnt : 1u;
}

__device__ __forceinline__ void xcd_barrier(const XcdBarrier& b) {
    asm volatile("s_waitcnt vmcnt(0)" ::: "memory");
    __syncthreads();
    if (threadIdx.x == 0) {
        unsigned* bar = b.bar;
        __builtin_amdgcn_s_waitcnt(0);
        unsigned nloc = b.st[0], nx = b.st[1];
        if (nloc == 0u) { xcd_barrier_complete(bar, b.x, nloc, nx); b.st[0] = nloc; b.st[1] = nx; }
        const unsigned old = xb_add(&bar[XB_XSUB(b.x)], 1u);
        const unsigned gen = old / nloc;
        if (old + 1u == (gen + 1u) * nloc) {
            __builtin_amdgcn_fence(__ATOMIC_RELEASE, "agent");
            asm volatile("s_waitcnt vmcnt(0)" ::: "memory");
            const unsigned og = xb_add(&bar[XB_TOP], 1u);
            const unsigned tg = og / nx;
            if (og + 1u == (tg + 1u) * nx) xb_add(&bar[XB_TOPGEN], 1u);
            else XB_SPIN(xb_ld(&bar[XB_TOPGEN]) == tg, bar);
            __builtin_amdgcn_fence(__ATOMIC_ACQUIRE, "agent");
            xb_add(&bar[XB_XGEN(b.x)], 1u);
            asm volatile("s_waitcnt vmcnt(0)" ::: "memory");
        } else {
            XB_SPIN(xb_ld(&bar[XB_XGEN(b.x)]) == gen, bar);
            __builtin_amdgcn_fence(__ATOMIC_ACQUIRE, "agent");
            asm volatile("s_waitcnt vmcnt(0)" ::: "memory");
        }
    }
    __syncthreads();
}
__device__ __forceinline__ f32x4 mfma16(bf16x8 a, bf16x8 b, f32x4 c) { return __builtin_amdgcn_mfma_f32_16x16x32_bf16(a, b, c, 0, 0, 0); }
__device__ __forceinline__ float grp16_max(float v) { v = fmaxf(v, __shfl_xor(v, 1)); v = fmaxf(v, __shfl_xor(v, 2)); v = fmaxf(v, __shfl_xor(v, 4)); v = fmaxf(v, __shfl_xor(v, 8)); return v; }
__device__ __forceinline__ float grp16_sum(float v) { v += __shfl_xor(v, 1); v += __shfl_xor(v, 2); v += __shfl_xor(v, 4); v += __shfl_xor(v, 8); return v; }
#define WAVE_SYNC() do { asm volatile("s_waitcnt lgkmcnt(0)" ::: "memory"); __builtin_amdgcn_wave_barrier(); asm volatile("" ::: "memory"); } while (0)
__device__ __forceinline__ v4u pack8(const float* f) { v4u o; o.x = pk2(f[0], f[1]); o.y = pk2(f[2], f[3]); o.z = pk2(f[4], f[5]); o.w = pk2(f[6], f[7]); return o; }
__device__ __forceinline__ void store_tile16x64(const f32x4 (&o)[4], LAS bf16* strip, int ld, bf16* gdst, size_t pitch, int lane) {
    const int fr = lane & 15, fq = lane >> 4;
#pragma unroll
    for (int nb = 0; nb < 4; ++nb)
#pragma unroll
        for (int j = 0; j < 4; ++j) strip[(4 * fq + j) * ld + nb * 16 + fr] = (bf16)f2bf(o[nb][j]);
    WAVE_SYNC();
    const int row = lane >> 2, c0 = (lane & 3) * 16;
    const v4u x0 = *(const LAS v4u*)(strip + row * ld + c0), x1 = *(const LAS v4u*)(strip + row * ld + c0 + 8);
    *(v4u*)(gdst + (size_t)row * pitch + c0) = x0; *(v4u*)(gdst + (size_t)row * pitch + c0 + 8) = x1;
    WAVE_SYNC();
}

constexpr int FA_Q = 0, FA_K = 18432, FA_VT = 36864, FA_P = 54272, FA_BIAS = 89088, FA_END = 91136;
template <bool LAT>
__device__ __forceinline__ void attn_item(KArgs a, int l, LAS unsigned char* lds, int item) {
    const int tid = opaque_tid(), lane = tid & 63, wave = tid >> 6, fr = lane & 15, fq = lane >> 4;
    const bf16* P = (const bf16*)(a->ws + WS_P); bf16* O = (bf16*)(a->ws + WS_O);
    LAS bf16* Qs = (LAS bf16*)(lds + FA_Q); LAS bf16* Ks = (LAS bf16*)(lds + FA_K); LAS bf16* Vt = (LAS bf16*)(lds + FA_VT);
    LAS bf16* Pw = (LAS bf16*)(lds + FA_P) + wave * (16 * 136); LAS float* bias = (LAS float*)(lds + FA_BIAS);
    int b, h, qtok0, R0 = 0, rp = 0;
    if (!LAT) { b = item >> 3; h = (item >> 1) & 3; qtok0 = b * 256 + (item & 1) * 128; }
    else { b = item >> 7; h = (item >> 5) & 3; rp = item & 31; qtok0 = TC + b * 4096 + rp * 128; R0 = min(max(2 * rp - 4, 0), 56); }
    __syncthreads();
#pragma unroll
    for (int i = tid; i < 1024; i += NTHR) { const int r = i >> 3, cc = i & 7; *(LAS v4u*)(Qs + r * 72 + cc * 8) = *(const v4u*)(P + (size_t)(qtok0 + r) * 3072 + C_NQ + h * 64 + cc * 8); }
    if (LAT) for (int i = tid; i < 465; i += NTHR) bias[i] = a->in[I_RPB][(size_t)(l * 4 + h) * 465 + i];
    float m[4], ls[4]; f32x4 o[4];
#pragma unroll
    for (int j = 0; j < 4; ++j) { m[j] = -1e30f; ls[j] = 0.f; o[j] = (f32x4){0.f, 0.f, 0.f, 0.f}; }
    const int qr = 2 * rp + (wave >> 2), r0q = min(max(qr - 4, 0), 56);
    const int nch = LAT ? 7 : 2;
    for (int ch = 0; ch < nch; ++ch) {
        if (ch) __syncthreads();
        if (LAT && ch < 2) {
            const float* ck = a->in[I_CK] + ((size_t)(b * 4 + l) * 256 + ch * 128) * 256 + h * 64; const float* cv = a->in[I_CV] + ((size_t)(b * 4 + l) * 256 + ch * 128) * 256 + h * 64;
#pragma unroll
            for (int i = tid; i < 1024; i += NTHR) { const int r = i >> 3, cc = i & 7; const f32x4 x0 = *(const f32x4*)(ck + (size_t)r * 256 + cc * 8), x1 = *(const f32x4*)(ck + (size_t)r * 256 + cc * 8 + 4);
                v4u w; w.x = pk2(x0.x, x0.y); w.y = pk2(x0.z, x0.w); w.z = pk2(x1.x, x1.y); w.w = pk2(x1.z, x1.w); *(LAS v4u*)(Ks + r * 72 + cc * 8) = w; }
#pragma unroll
            for (int i = tid; i < 1024; i += NTHR) { const int r = i & 127, cc = i >> 7; const f32x4 x0 = *(const f32x4*)(cv + (size_t)r * 256 + cc * 8), x1 = *(const f32x4*)(cv + (size_t)r * 256 + cc * 8 + 4);
                LAS bf16* d = Vt + (cc * 8) * 136 + r;
                d[0] = (bf16)f2bf(x0.x); d[136] = (bf16)f2bf(x0.y); d[272] = (bf16)f2bf(x0.z); d[408] = (bf16)f2bf(x0.w); d[544] = (bf16)f2bf(x1.x); d[680] = (bf16)f2bf(x1.y); d[816] = (bf16)f2bf(x1.z); d[952] = (bf16)f2bf(x1.w); }
        } else {
            const int c = ch - 2;
#pragma unroll
            for (int i = tid; i < 1024; i += NTHR) { const int r = i >> 3, cc = i & 7;
                const size_t tok = LAT ? (size_t)(TC + b * 4096 + min(R0 + 2 * c + (r >> 6), 63) * 64 + (r & 63)) : (size_t)(b * 256 + ch * 128 + r);
                *(LAS v4u*)(Ks + r * 72 + cc * 8) = *(const v4u*)(P + tok * 3072 + C_NK + h * 64 + cc * 8); }
#pragma unroll
            for (int i = tid; i < 1024; i += NTHR) { const int r = i & 127, cc = i >> 7;
                const size_t tok = LAT ? (size_t)(TC + b * 4096 + min(R0 + 2 * c + (r >> 6), 63) * 64 + (r & 63)) : (size_t)(b * 256 + ch * 128 + r);
                const v4u x = *(const v4u*)(P + tok * 3072 + C_NV + h * 64 + cc * 8);
                LAS bf16* d = Vt + (cc * 8) * 136 + r;
                d[0] = (bf16)(x.x & 0xffffu); d[136] = (bf16)(x.x >> 16); d[272] = (bf16)(x.y & 0xffffu); d[408] = (bf16)(x.y >> 16); d[544] = (bf16)(x.z & 0xffffu); d[680] = (bf16)(x.z >> 16); d[816] = (bf16)(x.w & 0xffffu); d[952] = (bf16)(x.w >> 16); }
        }
        __syncthreads();
        bf16x8 qa[2];
#pragma unroll
        for (int ks = 0; ks < 2; ++ks) qa[ks] = *(const LAS bf16x8*)(Qs + (16 * wave + fr) * 72 + ks * 32 + fq * 8);
        f32x4 s[8];
#pragma unroll
        for (int nb = 0; nb < 8; ++nb) { s[nb] = (f32x4){0.f, 0.f, 0.f, 0.f};
#pragma unroll
            for (int ks = 0; ks < 2; ++ks) s[nb] = mfma16(qa[ks], *(const LAS bf16x8*)(Ks + (nb * 16 + fr) * 72 + ks * 32 + fq * 8), s[nb]); }
        if (LAT && ch >= 2) {
            const int c = ch - 2;
#pragma unroll
            for (int j = 0; j < 4; ++j) { const int qc = (16 * wave + 4 * fq + j) & 63, c0q = min(max(qc - 8, 0), 48);
#pragma unroll
                for (int nb = 0; nb < 8; ++nb) { const int kr = R0 + 2 * c + (nb >> 2), kc = (nb & 3) * 16 + fr;
                    const bool ok = (kr >= r0q) && (kr < r0q + 8) && (kc >= c0q) && (kc < c0q + 16);
                    const int bi = ok ? (kr - qr + 7) * 31 + (kc - qc + 15) : 0;
                    s[nb][j] = ok ? s[nb][j] + bias[bi] : -1e30f; } }
        }
#pragma unroll
        for (int j = 0; j < 4; ++j) {
            float mx = s[0][j];
#pragma unroll
            for (int nb = 1; nb < 8; ++nb) mx = fmaxf(mx, s[nb][j]);
            mx = grp16_max(mx);
            const float mn = fmaxf(m[j], mx), al = __expf(m[j] - mn); m[j] = mn;
            float rs = 0.f;
#pragma unroll
            for (int nb = 0; nb < 8; ++nb) { const float p = __expf(s[nb][j] - mn); s[nb][j] = p; rs += p; }
            ls[j] = ls[j] * al + grp16_sum(rs);
#pragma unroll
            for (int nd = 0; nd < 4; ++nd) o[nd][j] *= al;
        }
#pragma unroll
        for (int nb = 0; nb < 8; ++nb)
#pragma unroll
            for (int j = 0; j < 4; ++j) Pw[(4 * fq + j) * 136 + nb * 16 + fr] = (bf16)f2bf(s[nb][j]);
        WAVE_SYNC();
#pragma unroll
        for (int ks = 0; ks < 4; ++ks) { const bf16x8 pa = *(const LAS bf16x8*)(Pw + fr * 136 + ks * 32 + fq * 8);
#pragma unroll
            for (int nd = 0; nd < 4; ++nd) o[nd] = mfma16(pa, *(const LAS bf16x8*)(Vt + (nd * 16 + fr) * 136 + ks * 32 + fq * 8), o[nd]); }
        WAVE_SYNC();
    }
#pragma unroll
    for (int j = 0; j < 4; ++j) { const float inv = 1.0f / ls[j];
#pragma unroll
        for (int nd = 0; nd < 4; ++nd) o[nd][j] *= inv; }
    store_tile16x64(o, Pw, 136, O + (size_t)(qtok0 + 16 * wave) * 1024 + 256 + h * 64, 1024, lane);
}
__device__ __forceinline__ void unpack8(v4u x, float* f) {
    f[0] = __builtin_bit_cast(float, x.x << 16); f[1] = __builtin_bit_cast(float, x.x & 0xffff0000u); f[2] = __builtin_bit_cast(float, x.y << 16); f[3] = __builtin_bit_cast(float, x.y & 0xffff0000u);
    f[4] = __builtin_bit_cast(float, x.z << 16); f[5] = __builtin_bit_cast(float, x.z & 0xffff0000u); f[6] = __builtin_bit_cast(float, x.w << 16); f[7] = __builtin_bit_cast(float, x.w & 0xffff0000u);
}
__device__ __forceinline__ float logsigf(float z) { return fminf(z, 0.f) - __logf(1.0f + __expf(-fabsf(z))); }
__device__ __forceinline__ void pool_item(KArgs a, int l, LAS unsigned char* lds, int item) {
    const int tid = opaque_tid(), lane = tid & 63, wave = tid >> 6, fr = lane & 15, fq = lane >> 4;
    const bf16* P = (const bf16*)(a->ws + WS_P); bf16* O = (bf16*)(a->ws + WS_O);
    LAS bf16* Vs = (LAS bf16*)lds; LAS bf16* Ds = (LAS bf16*)(lds + 36864); LAS bf16* Wt = (LAS bf16*)(lds + 73728);
    const int pm = item >> 2, g = item & 3, tok0 = pm * 256;
    __syncthreads();
#pragma unroll
    for (int i = tid; i < 2048; i += NTHR) { const int r = i >> 3, cc = i & 7; *(LAS v4u*)(Vs + r * 72 + cc * 8) = *(const v4u*)(P + (size_t)(tok0 + r) * 3072 + C_VP + g * 64 + cc * 8); }
    const float* pw = a->in[I_POOLW] + (size_t)(l * 4 + g) * 4096;
#pragma unroll
    for (int i = tid; i < 4096; i += NTHR) { const int c = i >> 6, dd = i & 63; Wt[dd * 72 + c] = (bf16)f2bf(pw[i]); }
    __syncthreads();
    const bool lat = pm >= 32; const int L = lat ? 64 : 256, win = 2 << g, left = win >> 1;
    for (int i = tid; i < 2048; i += NTHR) { const int t = i >> 3, cc = i & 7; const int pos = lat ? (t & 63) : t, base = t - pos;
        const int lo = max(pos - left, 0), hi = min(pos - left + win, L);
        float s[8], x[8];
#pragma unroll
        for (int e = 0; e < 8; ++e) s[e] = 0.f;
        for (int p = lo; p < hi; ++p) { unpack8(*(const LAS v4u*)(Vs + (base + p) * 72 + cc * 8), x);
#pragma unroll
            for (int e = 0; e < 8; ++e) s[e] += x[e]; }
        unpack8(*(const LAS v4u*)(Vs + t * 72 + cc * 8), x);
        const float inv = 1.0f / (float)(hi - lo);
#pragma unroll
        for (int e = 0; e < 8; ++e) s[e] = s[e] * inv - x[e];
        *(LAS v4u*)(Ds + t * 72 + cc * 8) = pack8(s); }
    __syncthreads();
    const float* psc = a->in[I_POOLS] + l * 256 + g * 64;
#pragma unroll
    for (int mb = 0; mb < 2; ++mb) { f32x4 y[4];
#pragma unroll
        for (int nb = 0; nb < 4; ++nb) y[nb] = (f32x4){0.f, 0.f, 0.f, 0.f};
#pragma unroll
        for (int ks = 0; ks < 2; ++ks) { const bf16x8 da = *(const LAS bf16x8*)(Ds + (32 * wave + 16 * mb + fr) * 72 + ks * 32 + fq * 8);
#pragma unroll
            for (int nb = 0; nb < 4; ++nb) y[nb] = mfma16(da, *(const LAS bf16x8*)(Wt + (nb * 16 + fr) * 72 + ks * 32 + fq * 8), y[nb]); }
#pragma unroll
        for (int nb = 0; nb < 4; ++nb) { const float sc = psc[nb * 16 + fr];
#pragma unroll
            for (int j = 0; j < 4; ++j) y[nb][j] *= sc; }
        store_tile16x64(y, Vs + wave * (16 * 72), 72, O + (size_t)(tok0 + 32 * wave + 16 * mb) * 1024 + g * 64, 1024, lane); }
}
__device__ __forceinline__ void rope_chunk8(const bf16* headrow, int cc, int n, const float2* tab, float* out) {
    float own[8], oth[8];
    unpack8(*(const v4u*)(headrow + cc * 8), own); unpack8(*(const v4u*)(headrow + (cc ^ 2) * 8), oth);
    const int pos = (cc & 4) ? (n & 63) : (n >> 6); const float2* t = tab + pos * 16 + (cc & 1) * 8;
    if (!(cc & 2)) {
#pragma unroll
        for (int e = 0; e < 8; ++e) out[e] = own[e] * t[e].x - oth[e] * t[e].y; }
    else {
#pragma unroll
        for (int e = 0; e < 8; ++e) out[e] = oth[e] * t[e].y + own[e] * t[e].x; }
}
__device__ __forceinline__ float sigmoidf_(float x) { return 1.0f / (1.0f + __expf(-x)); }
__device__ __forceinline__ void retu_item(KArgs a, int l, LAS unsigned char* lds, int item) {
    const int tid = opaque_tid(), lane = tid & 63, wave = tid >> 6, fr = lane & 15, fq = lane >> 4;
    const bf16* P = (const bf16*)(a->ws + WS_P); float* UR = (float*)(a->ws + WS_UR); const float2* tab = (const float2*)(a->ws + WS_ROPE);
    const int c = item >> 1, hp = item & 1, tok0 = c * 128; const bool lat = tok0 >= TC;
    __syncthreads();
#pragma unroll
    for (int hh = 0; hh < 2; ++hh) { const int h = 2 * hp + hh;
        LAS bf16* Ktf = (LAS bf16*)(lds + hh * 52224); LAS bf16* Ktb = Ktf + 64 * 136; LAS bf16* Vt = Ktb + 64 * 136;
        const float l2f = __log2f(sigmoidf_(a->in[I_RETL][(l * 2 + 0) * 4 + h])), l2b = __log2f(sigmoidf_(a->in[I_RETL][(l * 2 + 1) * 4 + h]));
#pragma unroll
        for (int i = tid; i < 1024; i += NTHR) { const int r = i & 127, cc = i >> 7; const bf16* rowp = P + (size_t)(tok0 + r) * 3072;
            float k[8];
            if (lat) rope_chunk8(rowp + C_RK + h * 64, cc, (tok0 + r - TC) & 4095, tab, k); else unpack8(*(const v4u*)(rowp + C_RK + h * 64 + cc * 8), k);
            const float wf = exp2f(l2f * (float)(127 - r)), wb = exp2f(l2b * (float)r);
            const v4u vx = *(const v4u*)(rowp + C_RV + h * 64 + cc * 8);
            LAS bf16* df = Ktf + (cc * 8) * 136 + r; LAS bf16* db = Ktb + (cc * 8) * 136 + r; LAS bf16* dv = Vt + (cc * 8) * 136 + r;
#pragma unroll
            for (int e = 0; e < 8; ++e) { df[e * 136] = (bf16)f2bf(k[e] * wf); db[e * 136] = (bf16)f2bf(k[e] * wb); }
            dv[0] = (bf16)(vx.x & 0xffffu); dv[136] = (bf16)(vx.x >> 16); dv[272] = (bf16)(vx.y & 0xffffu); dv[408] = (bf16)(vx.y >> 16); dv[544] = (bf16)(vx.z & 0xffffu); dv[680] = (bf16)(vx.z >> 16); dv[816] = (bf16)(vx.w & 0xffffu); dv[952] = (bf16)(vx.w >> 16); }
    }
    __syncthreads();
    { const int hh = wave >> 2, dir = (wave >> 1) & 1, mh = wave & 1, h = 2 * hp + hh;
      const LAS bf16* Kt = (const LAS bf16*)(lds + hh * 52224) + dir * (64 * 136); const LAS bf16* Vt = (const LAS bf16*)(lds + hh * 52224) + 2 * (64 * 136);
      float* dst = UR + ((size_t)(c * 4 + h) * 2 + dir) * 4096;
#pragma unroll
      for (int mi = 0; mi < 2; ++mi) { const int mb = 2 * mh + mi; f32x4 u[4];
#pragma unroll
          for (int nb = 0; nb < 4; ++nb) u[nb] = (f32x4){0.f, 0.f, 0.f, 0.f};
#pragma unroll
          for (int ks = 0; ks < 4; ++ks) { const bf16x8 ka = *(const LAS bf16x8*)(Kt + (mb * 16 + fr) * 136 + ks * 32 + fq * 8);
#pragma unroll
              for (int nb = 0; nb < 4; ++nb) u[nb] = mfma16(ka, *(const LAS bf16x8*)(Vt + (nb * 16 + fr) * 136 + ks * 32 + fq * 8), u[nb]); }
#pragma unroll
          for (int nb = 0; nb < 4; ++nb)
#pragma unroll
              for (int j = 0; j < 4; ++j) dst[(mb * 16 + 4 * fq + j) * 64 + nb * 16 + fr] = u[nb][j]; }
    }
}
constexpr int RO_Q = 0, RO_K = 18432, RO_VT = 36864, RO_P = 54272, RO_SF = 89088, RO_SB = 98304, RO_G = 107520;
__device__ __forceinline__ void reto_item(KArgs a, int l, LAS unsigned char* lds, int item) {
    const int tid = opaque_tid(), lane = tid & 63, wave = tid >> 6, fr = lane & 15, fq = lane >> 4;
    const bf16* P = (const bf16*)(a->ws + WS_P); bf16* O = (bf16*)(a->ws + WS_O); const float* SR = (const float*)(a->ws + WS_SR); const float2* tab = (const float2*)(a->ws + WS_ROPE);
    LAS bf16* Qs = (LAS bf16*)(lds + RO_Q); LAS bf16* Ks = (LAS bf16*)(lds + RO_K); LAS bf16* Vt = (LAS bf16*)(lds + RO_VT); LAS bf16* Pw = (LAS bf16*)(lds + RO_P) + wave * (16 * 136);
    LAS bf16* Sft = (LAS bf16*)(lds + RO_SF); LAS bf16* Sbt = (LAS bf16*)(lds + RO_SB); LAS bf16* Gs = (LAS bf16*)(lds + RO_G);
    const int c = item >> 2, h = item & 3, tok0 = c * 128; const bool lat = tok0 >= TC;
    const float l2f = __log2f(sigmoidf_(a->in[I_RETL][(l * 2 + 0) * 4 + h])), l2b = __log2f(sigmoidf_(a->in[I_RETL][(l * 2 + 1) * 4 + h]));
    __syncthreads();
#pragma unroll
    for (int i = tid; i < 1024; i += NTHR) { const int r = i >> 3, cc = i & 7; const bf16* rowp = P + (size_t)(tok0 + r) * 3072;
        if (lat) { float x[8]; rope_chunk8(rowp + C_RQ + h * 64, cc, (tok0 + r - TC) & 4095, tab, x); *(LAS v4u*)(Qs + r * 72 + cc * 8) = pack8(x);
                   rope_chunk8(rowp + C_RK + h * 64, cc, (tok0 + r - TC) & 4095, tab, x); *(LAS v4u*)(Ks + r * 72 + cc * 8) = pack8(x); }
        else { *(LAS v4u*)(Qs + r * 72 + cc * 8) = *(const v4u*)(rowp + C_RQ + h * 64 + cc * 8); *(LAS v4u*)(Ks + r * 72 + cc * 8) = *(const v4u*)(rowp + C_RK + h * 64 + cc * 8); }
        *(LAS v4u*)(Gs + r * 72 + cc * 8) = *(const v4u*)(rowp + C_RG + h * 64 + cc * 8); }
#pragma unroll
    for (int i = tid; i < 1024; i += NTHR) { const int r = i & 127, cc = i >> 7; const v4u vx = *(const v4u*)(P + (size_t)(tok0 + r) * 3072 + C_RV + h * 64 + cc * 8);
        LAS bf16* dv = Vt + (cc * 8) * 136 + r;
        dv[0] = (bf16)(vx.x & 0xffffu); dv[136] = (bf16)(vx.x >> 16); dv[272] = (bf16)(vx.y & 0xffffu); dv[408] = (bf16)(vx.y >> 16); dv[544] = (bf16)(vx.z & 0xffffu); dv[680] = (bf16)(vx.z >> 16); dv[816] = (bf16)(vx.w & 0xffffu); dv[952] = (bf16)(vx.w >> 16); }
    { const float* sf = SR + ((size_t)(c * 4 + h) * 2 + 0) * 4096; const float* sb = sf + 4096;
#pragma unroll
      for (int i = tid; i < 4096; i += NTHR) { const int dk = i >> 6, dv = i & 63; Sft[dv * 72 + dk] = (bf16)f2bf(sf[i]); Sbt[dv * 72 + dk] = (bf16)f2bf(sb[i]); } }
    __syncthreads();
    bf16x8 qa[2];
#pragma unroll
    for (int ks = 0; ks < 2; ++ks) qa[ks] = *(const LAS bf16x8*)(Qs + (16 * wave + fr) * 72 + ks * 32 + fq * 8);
    {   f32x4 s[8];
#pragma unroll
        for (int nb = 0; nb < 8; ++nb) { s[nb] = (f32x4){0.f, 0.f, 0.f, 0.f};
#pragma unroll
            for (int ks = 0; ks < 2; ++ks) s[nb] = mfma16(qa[ks], *(const LAS bf16x8*)(Ks + (nb * 16 + fr) * 72 + ks * 32 + fq * 8), s[nb]); }
#pragma unroll
        for (int nb = 0; nb < 8; ++nb)
#pragma unroll
            for (int j = 0; j < 4; ++j) { const int dd = (16 * wave + 4 * fq + j) - (nb * 16 + fr);
                const float wgt = dd > 0 ? exp2f(l2f * (float)dd) : (dd < 0 ? exp2f(l2b * (float)(-dd)) : 2.0f);
                Pw[(4 * fq + j) * 136 + nb * 16 + fr] = (bf16)f2bf(s[nb][j] * wgt); }
    }
    WAVE_SYNC();
    f32x4 o[4], of[4], ob[4];
#pragma unroll
    for (int nd = 0; nd < 4; ++nd) { o[nd] = (f32x4){0.f, 0.f, 0.f, 0.f}; of[nd] = o[nd]; ob[nd] = o[nd]; }
#pragma unroll
    for (int ks = 0; ks < 4; ++ks) { const bf16x8 pa = *(const LAS bf16x8*)(Pw + fr * 136 + ks * 32 + fq * 8);
#pragma unroll
        for (int nd = 0; nd < 4; ++nd) o[nd] = mfma16(pa, *(const LAS bf16x8*)(Vt + (nd * 16 + fr) * 136 + ks * 32 + fq * 8), o[nd]); }
#pragma unroll
    for (int ks = 0; ks < 2; ++ks)
#pragma unroll
        for (int nd = 0; nd < 4; ++nd) { of[nd] = mfma16(qa[ks], *(const LAS bf16x8*)(Sft + (nd * 16 + fr) * 72 + ks * 32 + fq * 8), of[nd]);
                                         ob[nd] = mfma16(qa[ks], *(const LAS bf16x8*)(Sbt + (nd * 16 + fr) * 72 + ks * 32 + fq * 8), ob[nd]); }
    WAVE_SYNC();
#pragma unroll
    for (int j = 0; j < 4; ++j) { const int i = 16 * wave + 4 * fq + j; const float wf = exp2f(l2f * (float)(i + 1)), wb = exp2f(l2b * (float)(128 - i));
        float sm = 0.f;
#pragma unroll
        for (int nd = 0; nd < 4; ++nd) { o[nd][j] += wf * of[nd][j] + wb * ob[nd][j]; sm += o[nd][j]; }
        const float mu = grp16_sum(sm) * (1.f / 64.f); float vs = 0.f;
#pragma unroll
        for (int nd = 0; nd < 4; ++nd) { o[nd][j] -= mu; vs += o[nd][j] * o[nd][j]; }
        const float rstd = 1.0f / sqrtf(grp16_sum(vs) * (1.f / 64.f) + GN_EPS);
#pragma unroll
        for (int nd = 0; nd < 4; ++nd) o[nd][j] *= rstd * siluf(bf2f(Gs[i * 72 + nd * 16 + fr])); }
    store_tile16x64(o, Pw, 136, O + (size_t)(tok0 + 16 * wave) * 1024 + 512 + h * 64, 1024, lane);
}
__device__ __forceinline__ void gla_gates(KArgs a, int l, int tok0, int h, LAS float* Bf, LAS float* Bb, int tid) {
    const float* LG = (const float*)(a->ws + WS_LG); const float* gb = a->in[I_GB] + l * 256 + h * 32;
#pragma unroll
    for (int i = tid; i < 4096; i += NTHR) { const int t = i >> 6, dir = (i >> 5) & 1, d = i & 31;
        const float z = LG[(size_t)(tok0 + t) * 256 + dir * 128 + h * 32 + d] + gb[dir * 128 + d];
        (dir ? Bb : Bf)[t * 33 + d] = logsigf(z) * 0.0625f; }
    __syncthreads();
    if (tid < 64) { const int d = tid & 31; float s = 0.f;
        if (tid < 32) { for (int t = 0; t < 64; ++t) { s += Bf[t * 33 + d]; Bf[t * 33 + d] = s; } }
        else { for (int t = 63; t >= 0; --t) { s += Bb[t * 33 + d]; Bb[t * 33 + d] = s; } } }
    __syncthreads();
}
__device__ __forceinline__ void glau_item(KArgs a, int l, LAS unsigned char* lds, int item) {
    const int tid = opaque_tid(), lane = tid & 63, wave = tid >> 6, fr = lane & 15, fq = lane >> 4;
    const bf16* P = (const bf16*)(a->ws + WS_P); float* UG = (float*)(a->ws + WS_UG); float* GG = (float*)(a->ws + WS_GG);
    LAS float* Bf = (LAS float*)lds; LAS float* Bb = (LAS float*)(lds + 8448); LAS bf16* Ktf = (LAS bf16*)(lds + 16896); LAS bf16* Ktb = (LAS bf16*)(lds + 21504); LAS bf16* Vt = (LAS bf16*)(lds + 26112);
    const int bk = item >> 2, h = item & 3, tok0 = bk * 64;
    __syncthreads();
    gla_gates(a, l, tok0, h, Bf, Bb, tid);
    if (tid < 256) { const int r = tid & 63, cc = tid >> 6; float k[8]; unpack8(*(const v4u*)(P + (size_t)(tok0 + r) * 3072 + C_AK + h * 32 + cc * 8), k);
#pragma unroll
        for (int e = 0; e < 8; ++e) { const int d = cc * 8 + e; Ktf[d * 72 + r] = (bf16)f2bf(k[e] * __expf(Bf[63 * 33 + d] - Bf[r * 33 + d])); Ktb[d * 72 + r] = (bf16)f2bf(k[e] * __expf(Bb[d] - Bb[r * 33 + d])); } }
    { const int r = tid & 63, cc = tid >> 6; const v4u vx = *(const v4u*)(P + (size_t)(tok0 + r) * 3072 + C_AV + h * 64 + cc * 8); LAS bf16* dv = Vt + (cc * 8) * 72 + r;
      dv[0] = (bf16)(vx.x & 0xffffu); dv[72] = (bf16)(vx.x >> 16); dv[144] = (bf16)(vx.y & 0xffffu); dv[216] = (bf16)(vx.y >> 16); dv[288] = (bf16)(vx.z & 0xffffu); dv[360] = (bf16)(vx.z >> 16); dv[432] = (bf16)(vx.w & 0xffffu); dv[504] = (bf16)(vx.w >> 16); }
    if (tid < 64) { const int dir = tid >> 5, d = tid & 31; GG[((size_t)(bk * 4 + h) * 2 + dir) * 32 + d] = __expf(dir ? Bb[d] : Bf[63 * 33 + d]); }
    __syncthreads();
    { const int dir = wave >> 2, mb = (wave >> 1) & 1, nh = wave & 1; const LAS bf16* Kt = dir ? Ktb : Ktf; float* dst = UG + ((size_t)(bk * 4 + h) * 2 + dir) * 2048;
      f32x4 u[2];
#pragma unroll
      for (int ni = 0; ni < 2; ++ni) u[ni] = (f32x4){0.f, 0.f, 0.f, 0.f};
#pragma unroll
      for (int ks = 0; ks < 2; ++ks) { const bf16x8 ka = *(const LAS bf16x8*)(Kt + (mb * 16 + fr) * 72 + ks * 32 + fq * 8);
#pragma unroll
          for (int ni = 0; ni < 2; ++ni) u[ni] = mfma16(ka, *(const LAS bf16x8*)(Vt + ((2 * nh + ni) * 16 + fr) * 72 + ks * 32 + fq * 8), u[ni]); }
#pragma unroll
      for (int ni = 0; ni < 2; ++ni)
#pragma unroll
          for (int j = 0; j < 4; ++j) dst[(mb * 16 + 4 * fq + j) * 64 + (2 * nh + ni) * 16 + fr] = u[ni][j]; }
}
__device__ __forceinline__ void glao_item(KArgs a, int l, LAS unsigned char* lds, int item) {
    const int tid = opaque_tid(), lane = tid & 63, wave = tid >> 6, fr = lane & 15, fq = lane >> 4;
    const bf16* P = (const bf16*)(a->ws + WS_P); bf16* O = (bf16*)(a->ws + WS_O); const float* SG = (const float*)(a->ws + WS_SG);
    LAS float* Bf = (LAS float*)lds; LAS float* Bb = (LAS float*)(lds + 8448);
    LAS bf16* Qf = (LAS bf16*)(lds + 16896); LAS bf16* Qb = (LAS bf16*)(lds + 22016); LAS bf16* Kf = (LAS bf16*)(lds + 27136); LAS bf16* Kb = (LAS bf16*)(lds + 32256);
    LAS bf16* Vt = (LAS bf16*)(lds + 37376); LAS bf16* Stf = (LAS bf16*)(lds + 46592); LAS bf16* Stb = (LAS bf16*)(lds + 51712); LAS bf16* Gs = (LAS bf16*)(lds + 56832);
    LAS bf16* Pw = (LAS bf16*)(lds + 66048) + (wave & 3) * (16 * 72);
    const int bk = item >> 2, h = item & 3, tok0 = bk * 64;
    __syncthreads();
    gla_gates(a, l, tok0, h, Bf, Bb, tid);
    if (tid < 256) { const int r = tid >> 2, cc = tid & 3; const bf16* rowp = P + (size_t)(tok0 + r) * 3072; float q[8], k[8], x[8];
        unpack8(*(const v4u*)(rowp + C_AQ + h * 32 + cc * 8), q); unpack8(*(const v4u*)(rowp + C_AK + h * 32 + cc * 8), k);
        float ef[8], eb[8];
#pragma unroll
        for (int e = 0; e < 8; ++e) { ef[e] = Bf[r * 33 + cc * 8 + e]; eb[e] = Bb[r * 33 + cc * 8 + e]; }
#pragma unroll
        for (int e = 0; e < 8; ++e) x[e] = q[e] * __expf(ef[e]);
        *(LAS v4u*)(Qf + r * 40 + cc * 8) = pack8(x);
#pragma unroll
        for (int e = 0; e < 8; ++e) x[e] = q[e] * __expf(eb[e]);
        *(LAS v4u*)(Qb + r * 40 + cc * 8) = pack8(x);
#pragma unroll
        for (int e = 0; e < 8; ++e) x[e] = k[e] * __expf(-ef[e]);
        *(LAS v4u*)(Kf + r * 40 + cc * 8) = pack8(x);
#pragma unroll
        for (int e = 0; e < 8; ++e) x[e] = k[e] * __expf(-eb[e]);
        *(LAS v4u*)(Kb + r * 40 + cc * 8) = pack8(x); }
    { const int r = tid & 63, cc = tid >> 6; const v4u vx = *(const v4u*)(P + (size_t)(tok0 + r) * 3072 + C_AV + h * 64 + cc * 8); LAS bf16* dv = Vt + (cc * 8) * 72 + r;
      dv[0] = (bf16)(vx.x & 0xffffu); dv[72] = (bf16)(vx.x >> 16); dv[144] = (bf16)(vx.y & 0xffffu); dv[216] = (bf16)(vx.y >> 16); dv[288] = (bf16)(vx.z & 0xffffu); dv[360] = (bf16)(vx.z >> 16); dv[432] = (bf16)(vx.w & 0xffffu); dv[504] = (bf16)(vx.w >> 16); }
    { const int r = tid >> 3, cc = tid & 7; *(LAS v4u*)(Gs + r * 72 + cc * 8) = *(const v4u*)(P + (size_t)(tok0 + r) * 3072 + C_AG + h * 64 + cc * 8); }
    { const float* sf = SG + ((size_t)(bk * 4 + h) * 2 + 0) * 2048; const float* sb = sf + 2048;
#pragma unroll
      for (int i = tid; i < 2048; i += NTHR) { const int dk = i >> 6, dv = i & 63; Stf[dv * 40 + dk] = (bf16)f2bf(sf[i]); Stb[dv * 40 + dk] = (bf16)f2bf(sb[i]); } }
    __syncthreads();
    if (wave < 4) {
        const int mb = wave;
        const bf16x8 qfa = *(const LAS bf16x8*)(Qf + (16 * mb + fr) * 40 + fq * 8), qba = *(const LAS bf16x8*)(Qb + (16 * mb + fr) * 40 + fq * 8);
#pragma unroll
        for (int nb = 0; nb < 4; ++nb) { const f32x4 z = (f32x4){0.f, 0.f, 0.f, 0.f};
            const f32x4 sf = mfma16(qfa, *(const LAS bf16x8*)(Kf + (nb * 16 + fr) * 40 + fq * 8), z), sb = mfma16(qba, *(const LAS bf16x8*)(Kb + (nb * 16 + fr) * 40 + fq * 8), z);
#pragma unroll
            for (int j = 0; j < 4; ++j) { const int i = 16 * mb + 4 * fq + j, jj = nb * 16 + fr; const float p = (jj <= i ? sf[j] : 0.f) + (jj >= i ? sb[j] : 0.f);
                Pw[(4 * fq + j) * 72 + nb * 16 + fr] = (bf16)f2bf(p); } }
        WAVE_SYNC();
        f32x4 o[4];
#pragma unroll
        for (int nd = 0; nd < 4; ++nd) o[nd] = (f32x4){0.f, 0.f, 0.f, 0.f};
#pragma unroll
        for (int ks = 0; ks < 2; ++ks) { const bf16x8 pa = *(const LAS bf16x8*)(Pw + fr * 72 + ks * 32 + fq * 8);
#pragma unroll
            for (int nd = 0; nd < 4; ++nd) o[nd] = mfma16(pa, *(const LAS bf16x8*)(Vt + (nd * 16 + fr) * 72 + ks * 32 + fq * 8), o[nd]); }
#pragma unroll
        for (int nd = 0; nd < 4; ++nd) { o[nd] = mfma16(qfa, *(const LAS bf16x8*)(Stf + (nd * 16 + fr) * 40 + fq * 8), o[nd]); o[nd] = mfma16(qba, *(const LAS bf16x8*)(Stb + (nd * 16 + fr) * 40 + fq * 8), o[nd]); }
        WAVE_SYNC();
        const float* ng = a->in[I_GNG] + l * 64;
#pragma unroll
        for (int j = 0; j < 4; ++j) { const int i = 16 * mb + 4 * fq + j; float ss = 0.f;
#pragma unroll
            for (int nd = 0; nd < 4; ++nd) ss += o[nd][j] * o[nd][j];
            const float rstd = 1.0f / sqrtf(grp16_sum(ss) * (1.f / 64.f) + RMS_EPS);
#pragma unroll
            for (int nd = 0; nd < 4; ++nd) o[nd][j] *= rstd * ng[nd * 16 + fr] * siluf(bf2f(Gs[i * 72 + nd * 16 + fr])); }
        store_tile16x64(o, Pw, 72, O + (size_t)(tok0 + 16 * mb) * 1024 + 768 + h * 64, 1024, lane);
    }
}
__device__ __forceinline__ void phase_m1b(KArgs a, int l) {
    const int tid = opaque_tid(); const int gt = blockIdx.x * NTHR + tid, NT = gridDim.x * NTHR;
    const float* UR = (const float*)(a->ws + WS_UR); float* SR = (float*)(a->ws + WS_SR); const float* UG = (const float*)(a->ws + WS_UG); float* SG = (float*)(a->ws + WS_SG); const float* GG = (const float*)(a->ws + WS_GG);
    const int mask = a->mask;
    if (mask & 8) for (int i = gt; i < 65536; i += NT) { const int e = i & 4095, dir = (i >> 12) & 1, h = (i >> 13) & 3, s = i >> 15;
        const float g128 = exp2f(128.0f * __log2f(sigmoidf_(a->in[I_RETL][(l * 2 + dir) * 4 + h])));
        float S = a->in[I_SR][((((size_t)s * 4 + l) * 2 + dir) * 4 + h) * 4096 + e];
        for (int n = 0; n < 32; ++n) { const int c = 64 + 32 * s + (dir ? 31 - n : n); const size_t o = ((size_t)(c * 4 + h) * 2 + dir) * 4096 + e; SR[o] = S; S = g128 * S + UR[o]; } }
    if (mask & 8) for (int i = gt; i < 1048576; i += NT) { const int e = i & 4095, dir = (i >> 12) & 1, h = (i >> 13) & 3, b = i >> 15;
        const float g128 = exp2f(128.0f * __log2f(sigmoidf_(a->in[I_RETL][(l * 2 + dir) * 4 + h])));
        const int c1 = dir ? 2 * b + 1 : 2 * b, c2 = dir ? 2 * b : 2 * b + 1;
        const size_t o1 = ((size_t)(c1 * 4 + h) * 2 + dir) * 4096 + e, o2 = ((size_t)(c2 * 4 + h) * 2 + dir) * 4096 + e;
        const float u1 = UR[o1]; SR[o1] = 0.f; SR[o2] = u1;
        a->out[O_SR + ((((size_t)b * 4 + l) * 2 + dir) * 4 + h) * 4096 + e] = g128 * u1 + UR[o2]; }
    if (mask & 16) for (int i = gt; i < 32768; i += NT) { const int e = i & 2047, d = e >> 6, dir = (i >> 11) & 1, h = (i >> 12) & 3, s = i >> 14;
        float S = a->in[I_SG][((((size_t)s * 4 + l) * 2 + dir) * 4 + h) * 2048 + e];
        for (int n = 0; n < 64; ++n) { const int bk = 128 + 64 * s + (dir ? 63 - n : n); const size_t q = (size_t)(bk * 4 + h) * 2 + dir; SG[q * 2048 + e] = S; S = GG[q * 32 + d] * S + UG[q * 2048 + e]; } }
    if (mask & 16) for (int i = gt; i < 524288; i += NT) { const int e = i & 2047, d = e >> 6, dir = (i >> 11) & 1, h = (i >> 12) & 3, b = i >> 14;
        float S = 0.f;
#pragma unroll
        for (int n = 0; n < 4; ++n) { const int bk = 4 * b + (dir ? 3 - n : n); const size_t q = (size_t)(bk * 4 + h) * 2 + dir; SG[q * 2048 + e] = S; S = GG[q * 32 + d] * S + UG[q * 2048 + e]; }
        a->out[O_SG + ((((size_t)b * 4 + l) * 2 + dir) * 4 + h) * 2048 + e] = S; }
}
__device__ __forceinline__ void phase_m1(KArgs a, int l, LAS unsigned char* lds) {
    const int G = gridDim.x; const int mask = a->mask;
    if (mask & 2) for (int it = blockIdx.x; it < 256; it += G) attn_item<true>(a, l, lds, it);
    if (mask & 1) for (int it = blockIdx.x; it < 256; it += G) attn_item<false>(a, l, lds, it);
    if (mask & 8) for (int it = blockIdx.x; it < 256; it += G) retu_item(a, l, lds, it);
    if (mask & 16) for (int it = blockIdx.x; it < 1024; it += G) glau_item(a, l, lds, it);
    if (mask & 4) for (int it = blockIdx.x; it < 256; it += G) pool_item(a, l, lds, it);
    __syncthreads();
}
__device__ __forceinline__ void phase_m2(KArgs a, int l, LAS unsigned char* lds) {
    const int G = gridDim.x; const int mask = a->mask;
    if (mask & 32) for (int it = blockIdx.x; it < 512; it += G) reto_item(a, l, lds, it);
    if (mask & 64) for (int it = blockIdx.x; it < 1024; it += G) glao_item(a, l, lds, it);
    __syncthreads();
}
__global__ void __launch_bounds__(NTHR, 2) mega(Args args) {
    extern __shared__ __attribute__((aligned(16))) unsigned char lds_raw[];
    LAS unsigned char* lds = (LAS unsigned char*)lds_raw;
    const int G = gridDim.x;
    if (threadIdx.x < 32) ((LAS unsigned*)(lds + LDSCTL_OFF))[threadIdx.x + 80] = 0u;
    __syncthreads();
    XcdBarrier bar; bar.bar = (unsigned*)(args.ws + WS_CTL) + CW_BAR; bar.x = 0; bar.st = nullptr;
    if (args.ph_hi - args.ph_lo > 1) bar = xcd_barrier_post((unsigned*)(args.ws + WS_CTL) + CW_BAR, (volatile LAS unsigned*)(lds + MISC_OFF) + 8);
    for (int ph = args.ph_lo; ph < args.ph_hi; ++ph) {
        KArgs a = kargs(); unsigned char* ws = a->ws;
        if (ph == 0) phase_p0a(a, lds);
        else if (ph == 1) phase_p0b(a);
        else {
            const int l = (ph - 2) / 9, k = (ph - 2) % 9;
            if (k == 0) {
                pg8::Gemm g{(const pg8::bf16_t*)(ws + WS_H), (const pg8::bf16_t*)(ws + WS_W1 + l * W1_L), T, NP, D}; pg8::StaticOrder S; S.init(T, NP, G, (int)blockIdx.x);
                pg8::EpiG1 E{(pg8::bf16_t*)(ws + WS_P), (float*)(ws + WS_LG), a->out + O_CK, a->out + O_CV, l};
                pg8::gemm_phase<pg8::EpiG1, pg8::StaticOrder, true, true>(lds + RING_OFF, g, S, E);
            } else if (k == 4 || k == 7) {
                pg8::Gemm g = (k == 4) ? pg8::Gemm{(const pg8::bf16_t*)(ws + WS_O), (const pg8::bf16_t*)(ws + WS_W2 + l * W2_L), T, D, D}
                                       : pg8::Gemm{(const pg8::bf16_t*)(ws + WS_U3), (const pg8::bf16_t*)(ws + WS_W4 + l * W4_L), T, D, DFF};
                pg8::StaticOrder S; S.init(T, D, G, (int)blockIdx.x);
                pg8::EpiF32 E{(float*)(ws + WS_Y), D};
                pg8::gemm_phase<pg8::EpiF32, pg8::StaticOrder, true, true>(lds + RING_OFF, g, S, E);
            } else if (k == 6) {
                pg8::Gemm g{(const pg8::bf16_t*)(ws + WS_H), (const pg8::bf16_t*)(ws + WS_W3 + l * W3_L), T, N3, D}; pg8::StaticOrder S; S.init(T, N3, G, (int)blockIdx.x);
                pg8::EpiG3 E{(pg8::bf16_t*)(ws + WS_U3)};
                pg8::gemm_phase<pg8::EpiG3, pg8::StaticOrder, true, true>(lds + RING_OFF, g, S, E);
            } else if (k == 1) phase_m1(a, l, lds);
            else if (k == 2) phase_m1b(a, l);
            else if (k == 3) phase_m2(a, l, lds);
            else if (k == 5) phase_rowpass(a, l, 0);
            else if (k == 8) phase_rowpass(a, l, 1);
        }
        if (ph + 1 < args.ph_hi) { if (ph == args.ph_lo) cg::this_grid().sync(); else xcd_barrier(bar); }
    }
}

extern "C" void kernel_launch(void* const* d_in, const int* in_sizes, int n_in, void* d_out, int out_size, void* d_ws, size_t ws_size, hipStream_t stream) {
    static int grid = 0;
    if (grid == 0) {
        if (n_in != N_IN || (size_t)out_size != O_END || ws_size < WS_END) { fprintf(stderr, "kernel_launch: unexpected shapes: n_in %d out %d ws %zu (need %zu)\n", n_in, out_size, ws_size, (size_t)WS_END); grid = -1; return; }
        int dev = 0, cus = 0, per_cu = 0;
        if (hipGetDevice(&dev) != hipSuccess || hipDeviceGetAttribute(&cus, hipDeviceAttributeMultiprocessorCount, dev) != hipSuccess) { grid = -1; return; }
        if (hipFuncSetAttribute((const void*)mega, hipFuncAttributeMaxDynamicSharedMemorySize, LDS_BYTES) != hipSuccess) { fprintf(stderr, "kernel_launch: hipFuncSetAttribute failed\n"); grid = -1; return; }
        if (hipOccupancyMaxActiveBlocksPerMultiprocessor(&per_cu, (const void*)mega, NTHR, LDS_BYTES) != hipSuccess || per_cu < 1) { fprintf(stderr, "kernel_launch: occupancy query says %d\n", per_cu); per_cu = 1; }
        (void)hipGetLastError();
        grid = cus;
    }
    if (grid < 0) return;
    if (hipMemsetAsync((char*)d_ws + WS_CTL, 0, CTL_ZERO_BYTES, stream) != hipSuccess) { fprintf(stderr, "kernel_launch: memset failed\n"); return; }
    Args a{};
    for (int i = 0; i < N_IN; ++i) a.in[i] = (const float*)d_in[i];
    a.out = (float*)d_out; a.ws = (unsigned char*)d_ws;
    unsigned char* ws = (unsigned char*)d_ws;
    auto run = [&](int lo, int hi, int mask = 0) {
        a.ph_lo = lo; a.ph_hi = hi; a.coop = 0; a.mask = mask;
        if (hi - lo > 1) { void* args[] = {&a}; hipError_t e = hipLaunchCooperativeKernel((const void*)mega, dim3(grid), dim3(NTHR), args, LDS_BYTES, stream); if (e != hipSuccess) fprintf(stderr, "coop launch failed: %s\n", hipGetErrorString(e)); }
        else hipLaunchKernelGGL(mega, dim3(grid), dim3(NTHR), LDS_BYTES, stream, a);
    };
#ifndef MK_MULTI
#define MK_MULTI 0
#endif
    if (!MK_MULTI) { run(0, NPH, 127); return; }
    run(0, 2);
    for (int l = 0; l < DEPTH; ++l) { const int b = 2 + 9 * l; run(b, b + 1); run(b + 1, b + 2, 127); run(b + 2, b + 3, 127); run(b + 3, b + 4, 127); run(b + 4, b + 9); }
}
```

```cpp
#include <hip/hip_runtime.h>
#include <hip/hip_cooperative_groups.h>
#include <cstdio>
#include <cstdint>
namespace cg = cooperative_groups;

constexpr int T = 16384, TC = 8192, D = 1024, NP = 3072, PIN = 2832, DFF = 2816, N3 = 5632, DEPTH = 4;
constexpr int C_VP = 0, C_NQ = 256, C_NK = 512, C_NV = 768, C_RQ = 1024, C_RK = 1280, C_RV = 1536, C_RG = 1792, C_AQ = 2048, C_AK = 2176, C_AV = 2304, C_AG = 2560;
constexpr float RMS_EPS = 1e-6f, GN_EPS = 1e-5f;
enum { I_XP = 0, I_XS, I_CK, I_CV, I_SR, I_SG, I_C, I_CCTX, I_WMOD, I_BMOD, I_GPM, I_GQM, I_GPF, I_GQF, I_WIN, I_WOUT, I_POOLW, I_POOLS, I_RPB, I_RETL, I_GUP, I_GB, I_GNG, I_WG, I_WU, I_WD, N_IN };
constexpr size_t O_Y = 0, O_CK = (size_t)T * D, O_CV = O_CK + 8388608, O_SR = O_CV + 8388608, O_SG = O_SR + 4194304, O_END = O_SG + 2097152;
constexpr size_t MiB = 1u << 20;
constexpr size_t WS_CTL = 0, CTL_ZERO_BYTES = 1 * MiB;
constexpr size_t WS_MOD = 1 * MiB;
constexpr size_t WS_ROPE = WS_MOD + 512 * 1024;
constexpr size_t WS_W1 = 2 * MiB, W1_L = (size_t)NP * D * 2;
constexpr size_t WS_W2 = WS_W1 + 4 * W1_L, W2_L = (size_t)D * D * 2;
constexpr size_t WS_W3 = WS_W2 + 4 * W2_L, W3_L = (size_t)N3 * D * 2;
constexpr size_t WS_W4 = WS_W3 + 4 * W3_L, W4_L = (size_t)D * DFF * 2;
constexpr size_t WS_H = WS_W4 + 4 * W4_L;
constexpr size_t WS_O = WS_H + (size_t)T * D * 2;
constexpr size_t WS_BIG = WS_O + (size_t)T * D * 2;
constexpr size_t WS_P = WS_BIG;
constexpr size_t WS_U3 = WS_BIG;
constexpr size_t WS_Y = WS_BIG + (size_t)T * NP * 2;
constexpr size_t WS_LG = WS_Y;
constexpr size_t WS_SCAN = WS_LG + (size_t)T * 256 * 4;
constexpr size_t WS_UR = WS_SCAN, WS_SR = WS_SCAN + 16 * MiB, WS_UG = WS_SCAN + 32 * MiB, WS_SG = WS_SCAN + 48 * MiB, WS_GG = WS_SCAN + 64 * MiB;
constexpr size_t WS_NAIVE = WS_SCAN + 66 * MiB;
constexpr size_t WS_END = WS_NAIVE + 32 * MiB;
namespace pg8 {
#define PG8_LAS __attribute__((address_space(3)))
typedef unsigned short bf16_t;
typedef short bf16x8 __attribute__((ext_vector_type(8)));
typedef float f32x4 __attribute__((ext_vector_type(4)));
typedef unsigned u32x4 __attribute__((ext_vector_type(4)));
constexpr int BM = 256, BK = 64, HALF = 128, HTB = HALF * BK * 2  , STAGE_BYTES = 8 * HTB, NXCD = 8, WGM = 8;

__host__ __device__ __forceinline__ int lds_byte(int r, int c) { const int st = (r >> 4) * 2 + (c >> 5), rr = r & 15, cc = c & 31, ob = rr * 64 + cc * 2; return st * 1024 + (ob ^ (((ob >> 9) & 1) << 5)); }
__host__ __device__ __forceinline__ void stage_rc(int b, int& R, int& C) { const int st = b / 1024, sb = b % 1024, swz = sb ^ (((sb >> 9) & 1) << 5); R = (st >> 1) * 16 + swz / 64; C = (st & 1) * 32 + (swz % 64) / 2; }
__host__ __device__ __forceinline__ int perm32(int rho) { const int n = rho >> 4, i = rho & 15; return 8 * (i >> 2) + 4 * n + (i & 3); }

struct Unit { int pm, pn; };
struct Gemm { const bf16_t* A; const bf16_t* Bt; int M, N, K; };

struct StaticOrder {
    int nM, nN, nwg, G, c;
    __host__ __device__ void init(int M, int N, int G_, int c_) { nM = M / BM; nN = N / BM; nwg = nM * nN; G = G_; c = c_; }
    __host__ __device__ bool next(int i, Unit& u) const {
        const long L = (long)i * G + c; if (L >= nwg) return false;
        int wgid = (int)L; { const int q = nwg / NXCD, r = nwg % NXCD, xcd = wgid % NXCD, off = wgid / NXCD; wgid = (xcd < r ? xcd * (q + 1) : r * (q + 1) + (xcd - r) * q) + off; }
        const int nig = WGM * nN, gid = wgid / nig, fm = gid * WGM, gsz = (nM - fm) < WGM ? (nM - fm) : WGM;
        u.pm = fm + ((wgid % nig) % gsz); u.pn = (wgid % nig) / gsz; return true;
    }
    __device__ __forceinline__ void a_ready(const Unit&) const {}
    __device__ __forceinline__ void done(const Unit&) const {}
};

__device__ __forceinline__ unsigned cvt_pk_bf16(float lo, float hi) { unsigned r; asm volatile("v_cvt_pk_bf16_f32 %0, %1, %2" : "=v"(r) : "v"(lo), "v"(hi)); return r; }
__device__ __forceinline__ float siluf(float x) { return x / (1.0f + __expf(-x)); }
__device__ __forceinline__ float logsigf(float z) { return fminf(z, 0.f) - log1pf(__expf(-fabsf(z))); }
struct EpiG1 {
    static constexpr bool PERM = true, AFTER_DRAIN = false;
    bf16_t* P; float* LG; float* outK; float* outV; int layer;
    __device__ __forceinline__ void operator()(const f32x4 (&acc)[2][2][4][2], const Unit& u, int wr, int wc, int fr, int fq) const {
        const int lrow = wr * 64 + fr, cl = wc * 32 + 8 * fq;
        if (u.pn < 11) {
            bf16_t* rowp = P + (size_t)(u.pm * BM + lrow) * 3072 + u.pn * BM + cl;
#pragma unroll
            for (int ai = 0; ai < 2; ++ai)
#pragma unroll
                for (int m = 0; m < 4; ++m) {
#pragma unroll
                    for (int bj = 0; bj < 2; ++bj) { const f32x4 v0 = acc[ai][bj][m][0], v1 = acc[ai][bj][m][1];
                        u32x4 w; w.x = cvt_pk_bf16(v0[0], v0[1]); w.y = cvt_pk_bf16(v0[2], v0[3]); w.z = cvt_pk_bf16(v1[0], v1[1]); w.w = cvt_pk_bf16(v1[2], v1[3]);
                        *(u32x4*)(rowp + (size_t)(ai * HALF + m * 16) * 3072 + bj * HALF) = w; }
                    asm volatile("" ::: "memory"); }
        }
        float* f32dst = nullptr;
        if (u.pn == 11) f32dst = LG + (size_t)u.pm * (BM * 256);
        else if ((u.pn == 2 || u.pn == 3) && u.pm < 32) f32dst = (u.pn == 2 ? outK : outV) + (size_t)(u.pm * 4 + layer) * (256 * 256);
        if (f32dst) {
            float* rowp = f32dst + (size_t)lrow * 256 + cl;
#pragma unroll
            for (int ai = 0; ai < 2; ++ai)
#pragma unroll
                for (int m = 0; m < 4; ++m) {
#pragma unroll
                    for (int bj = 0; bj < 2; ++bj) { *(f32x4*)(rowp + (ai * HALF + m * 16) * 256 + bj * HALF) = acc[ai][bj][m][0]; *(f32x4*)(rowp + (ai * HALF + m * 16) * 256 + bj * HALF + 4) = acc[ai][bj][m][1]; }
                    asm volatile("" ::: "memory"); }
        }
    }
};
struct EpiF32 {
    static constexpr bool PERM = false, AFTER_DRAIN = false;
    float* C; int ldc;
    __device__ __forceinline__ void operator()(const f32x4 (&acc)[2][2][4][2], const Unit& u, int wr, int wc, int fr, int fq) const {
        const int row0 = u.pm * BM + wr * 64 + fr, col0 = u.pn * BM + wc * 32 + 4 * fq;
#pragma unroll
        for (int ai = 0; ai < 2; ++ai)
#pragma unroll
            for (int m = 0; m < 4; ++m) { float* rowp = C + (size_t)(row0 + ai * HALF + m * 16) * ldc + col0;
#pragma unroll
                for (int bj = 0; bj < 2; ++bj)
#pragma unroll
                    for (int n = 0; n < 2; ++n) *(f32x4*)(rowp + bj * HALF + n * 16) = acc[ai][bj][m][n]; }
    }
};
struct EpiG3 {
    static constexpr bool PERM = true, AFTER_DRAIN = false;
    bf16_t* U;
    __device__ __forceinline__ void operator()(const f32x4 (&acc)[2][2][4][2], const Unit& u, int wr, int wc, int fr, int fq) const {
        const int row0 = u.pm * BM + wr * 64 + fr, col0 = u.pn * HALF + wc * 32 + 8 * fq;
#pragma unroll
        for (int ai = 0; ai < 2; ++ai)
#pragma unroll
            for (int m = 0; m < 4; ++m) { f32x4 v0, v1;
#pragma unroll
                for (int j = 0; j < 4; ++j) { v0[j] = siluf(acc[ai][0][m][0][j]) * acc[ai][1][m][0][j]; v1[j] = siluf(acc[ai][0][m][1][j]) * acc[ai][1][m][1][j]; }
                u32x4 w; w.x = cvt_pk_bf16(v0[0], v0[1]); w.y = cvt_pk_bf16(v0[2], v0[3]); w.z = cvt_pk_bf16(v1[0], v1[1]); w.w = cvt_pk_bf16(v1[2], v1[3]);
                *(u32x4*)(U + (size_t)(row0 + ai * HALF + m * 16) * 2816 + col0) = w; }
    }
};
template <class Epi, class Sched, bool ALIGN_EPI = false, bool SP2 = false>
__device__ __forceinline__ void gemm_phase(PG8_LAS unsigned char* lds, const Gemm g, const Sched& S, const Epi& E) {
    int tid_ = threadIdx.x; asm volatile("" : "+v"(tid_)); const int tid = tid_, wid = __builtin_amdgcn_readfirstlane(tid >> 6), lane = tid & 63, wr = wid >> 2, wc = wid & 3, fr = lane & 15, fq = lane >> 4;
    const int K = g.K, nt = K / BK;
    unsigned voffA[2], voffB[2];
#pragma unroll
    for (int i = 0; i < 2; ++i) { int R, C; stage_rc(tid * 16 + i * 8192, R, C); const int Rb = Epi::PERM ? ((R & ~31) + perm32(R & 31)) : R;
        voffA[i] = (unsigned)(R * K + C) * 2u; voffB[i] = (unsigned)(Rb * K + C) * 2u; }
    const size_t kstep = (size_t)(BK * 2);
    const size_t hstep = (size_t)HALF * K * 2;
    const size_t tstep = 2 * hstep;
    const unsigned ldsw = (unsigned)wid * 1024u;
    const int aoff = lds_byte(wr * 64 + fr, fq * 8), boff = lds_byte(wc * 32 + fr, fq * 8);
#define PG8_SA(b, h) (((b) * 2 + (h)) * HTB)
#define PG8_SB(b, h) ((4 + (b) * 2 + (h)) * HTB)
#define PG8_STAGE(bufoff, gbase, voff) do { _Pragma("unroll") for (int _i = 0; _i < 2; ++_i) \
        __builtin_amdgcn_global_load_lds((const unsigned*)((const char*)(gbase) + (voff)[_i]), (PG8_LAS unsigned*)(lds + (bufoff) + ldsw + _i * 8192), 16, 0, 0); } while (0)
#define PG8_LDA(dst, b, h) do { _Pragma("unroll") for (int m = 0; m < 4; ++m) _Pragma("unroll") for (int k = 0; k < 2; ++k) dst[m][k] = *(const PG8_LAS bf16x8*)(lds + PG8_SA(b, h) + aoff + m * 2048 + k * 1024); } while (0)
#define PG8_LDB(dst, b, h) do { _Pragma("unroll") for (int n = 0; n < 2; ++n) _Pragma("unroll") for (int k = 0; k < 2; ++k) dst[n][k] = *(const PG8_LAS bf16x8*)(lds + PG8_SB(b, h) + boff + n * 2048 + k * 1024); } while (0)
#define PG8_MMA(ai, bj, At, Bt) do { __builtin_amdgcn_s_setprio(1); _Pragma("unroll") for (int m = 0; m < 4; ++m) _Pragma("unroll") for (int n = 0; n < 2; ++n) _Pragma("unroll") for (int k = 0; k < 2; ++k) \
        acc[ai][bj][m][n] = __builtin_amdgcn_mfma_f32_16x16x32_bf16(Bt[n][k], At[m][k], acc[ai][bj][m][n], 0, 0, 0); __builtin_amdgcn_s_setprio(0); } while (0)
#define PG8_WAIT_V(n) asm volatile("s_waitcnt vmcnt(" #n ")" ::: "memory")
#define PG8_WAIT_L(n) asm volatile("s_waitcnt lgkmcnt(" #n ")" ::: "memory")
#define PG8_BAR __builtin_amdgcn_s_barrier()
#define PG8_SCHED __builtin_amdgcn_sched_barrier(0)
    Unit cur, nxt; int ui = 0;
    if (!S.next(0, cur)) return;
    f32x4 acc[2][2][4][2];
#pragma unroll
    for (int a = 0; a < 2; ++a)
#pragma unroll
        for (int b = 0; b < 2; ++b)
#pragma unroll
            for (int m = 0; m < 4; ++m)
#pragma unroll
                for (int n = 0; n < 2; ++n) acc[a][b][m][n] = (f32x4){0.f, 0.f, 0.f, 0.f};
    bf16x8 At[4][2], B0[2][2], B1[2][2];
    const char* cA = (const char*)g.A + (size_t)cur.pm * tstep; const char* cB = (const char*)g.Bt + (size_t)cur.pn * tstep;
    S.a_ready(cur);
    if constexpr (SP2) {
        PG8_STAGE(PG8_SB(0, 0), cB, voffB); PG8_STAGE(PG8_SB(0, 1), cB + hstep, voffB); PG8_STAGE(PG8_SA(0, 0), cA, voffA); PG8_STAGE(PG8_SA(0, 1), cA + hstep, voffA);
        if (wr == 1) PG8_BAR;
        PG8_WAIT_V(2); PG8_BAR;
        PG8_STAGE(PG8_SB(1, 0), cB + kstep, voffB); PG8_STAGE(PG8_SA(1, 0), cA + kstep, voffA); PG8_STAGE(PG8_SB(1, 1), cB + hstep + kstep, voffB);
        PG8_WAIT_V(6); PG8_BAR;
    } else {
        PG8_STAGE(PG8_SB(0, 0), cB, voffB); PG8_STAGE(PG8_SA(0, 0), cA, voffA); PG8_STAGE(PG8_SB(0, 1), cB + hstep, voffB); PG8_STAGE(PG8_SA(0, 1), cA + hstep, voffA);
        if (wr == 1) PG8_BAR;
        PG8_WAIT_V(4); PG8_BAR;
        PG8_STAGE(PG8_SB(1, 0), cB + kstep, voffB); PG8_STAGE(PG8_SA(1, 0), cA + kstep, voffA); PG8_STAGE(PG8_SB(1, 1), cB + hstep + kstep, voffB);
        PG8_WAIT_V(6); PG8_BAR;
    }
    for (;;) {
        const bool has_next = S.next(ui + 1, nxt);
        const char* nA = has_next ? (const char*)g.A + (size_t)nxt.pm * tstep : cA; const char* nB = has_next ? (const char*)g.Bt + (size_t)nxt.pn * tstep : cB;
        for (int t = 0; t < nt; t += 2) {
            const bool last = (t == nt - 2);
            const char* a1 = cA + (size_t)(t + 1) * kstep;
            const char* a2 = last ? nA : cA + (size_t)(t + 2) * kstep; const char* b2 = last ? nB : cB + (size_t)(t + 2) * kstep;
            const char* a3 = a2 + kstep; const char* b3 = b2 + kstep;
            if (last && has_next) S.a_ready(nxt);
            if constexpr (SP2) {
            PG8_LDB(B0, 0, 0); PG8_LDB(B1, 0, 1); PG8_SCHED; PG8_LDA(At, 0, 0); PG8_STAGE(PG8_SA(1, 1), a1 + hstep, voffA);
            PG8_WAIT_V(8); PG8_WAIT_L(0); PG8_BAR; PG8_MMA(0, 0, At, B0); PG8_MMA(0, 1, At, B1); PG8_BAR; PG8_SCHED;
            PG8_LDA(At, 0, 1); PG8_STAGE(PG8_SB(0, 0), b2, voffB); PG8_STAGE(PG8_SB(0, 1), b2 + hstep, voffB); PG8_STAGE(PG8_SA(0, 0), a2, voffA);
            PG8_WAIT_V(8); PG8_WAIT_L(0); PG8_BAR; PG8_MMA(1, 0, At, B0); PG8_MMA(1, 1, At, B1); PG8_BAR; PG8_SCHED;
            PG8_LDB(B0, 1, 0); PG8_LDB(B1, 1, 1); PG8_SCHED; PG8_LDA(At, 1, 0); PG8_STAGE(PG8_SA(0, 1), a2 + hstep, voffA);
            PG8_WAIT_V(8); PG8_WAIT_L(0); PG8_BAR; PG8_MMA(0, 0, At, B0); PG8_MMA(0, 1, At, B1); PG8_BAR; PG8_SCHED;
            PG8_LDA(At, 1, 1); PG8_STAGE(PG8_SB(1, 0), b3, voffB); PG8_STAGE(PG8_SB(1, 1), b3 + hstep, voffB); PG8_STAGE(PG8_SA(1, 0), a3, voffA);
            PG8_WAIT_V(8); PG8_WAIT_L(0); PG8_BAR; PG8_MMA(1, 0, At, B0); PG8_MMA(1, 1, At, B1); PG8_BAR; PG8_SCHED;
            } else {
            PG8_LDB(B0, 0, 0); PG8_SCHED; PG8_LDA(At, 0, 0); PG8_STAGE(PG8_SA(1, 1), a1 + hstep, voffA);
            PG8_WAIT_L(8); PG8_BAR; PG8_WAIT_L(0); PG8_MMA(0, 0, At, B0); PG8_BAR; PG8_SCHED;
            PG8_LDB(B1, 0, 1); PG8_STAGE(PG8_SB(0, 0), b2, voffB);
            PG8_BAR; PG8_WAIT_L(0); PG8_MMA(0, 1, At, B1); PG8_BAR;
            PG8_LDA(At, 0, 1); PG8_STAGE(PG8_SA(0, 0), a2, voffA);
            PG8_BAR; PG8_WAIT_L(0); PG8_MMA(1, 0, At, B0); PG8_BAR; PG8_SCHED;
            PG8_STAGE(PG8_SB(0, 1), b2 + hstep, voffB);
            PG8_WAIT_V(6); PG8_BAR; PG8_MMA(1, 1, At, B1); PG8_BAR;
            PG8_LDB(B0, 1, 0); PG8_SCHED; PG8_LDA(At, 1, 0); PG8_STAGE(PG8_SA(0, 1), a2 + hstep, voffA);
            PG8_WAIT_L(8); PG8_BAR; PG8_WAIT_L(0); PG8_MMA(0, 0, At, B0); PG8_BAR; PG8_SCHED;
            PG8_LDB(B1, 1, 1); PG8_STAGE(PG8_SB(1, 0), b3, voffB);
            PG8_BAR; PG8_WAIT_L(0); PG8_MMA(0, 1, At, B1); PG8_BAR;
            PG8_LDA(At, 1, 1); PG8_STAGE(PG8_SA(1, 0), a3, voffA);
            PG8_BAR; PG8_WAIT_L(0); PG8_MMA(1, 0, At, B0); PG8_BAR; PG8_SCHED;
            PG8_STAGE(PG8_SB(1, 1), b3 + hstep, voffB);
            PG8_WAIT_V(6); PG8_BAR; PG8_MMA(1, 1, At, B1); PG8_BAR;
            }
        }
        if constexpr (ALIGN_EPI) { if (wr == 0) PG8_BAR; }
        if constexpr (!Epi::AFTER_DRAIN) { E(acc, cur, wr, wc, fr, fq); S.done(cur); }
        if (!has_next) break;
#pragma unroll
        for (int a = 0; a < 2; ++a)
#pragma unroll
            for (int b = 0; b < 2; ++b)
#pragma unroll
                for (int m = 0; m < 4; ++m)
#pragma unroll
                    for (int n = 0; n < 2; ++n) acc[a][b][m][n] = (f32x4){0.f, 0.f, 0.f, 0.f};
        cur = nxt; cA = nA; cB = nB; ++ui;
        if constexpr (ALIGN_EPI) { if (wr == 1) PG8_BAR; }
    }
    PG8_WAIT_V(0);
    if constexpr (!ALIGN_EPI) { if (wr == 0) PG8_BAR; }
    PG8_BAR;
    if constexpr (Epi::AFTER_DRAIN) { E.fused(acc, cur, wr, wc, fr, fq, lds, wid, lane); S.done(cur); }
#undef PG8_SA
#undef PG8_SB
#undef PG8_STAGE
#undef PG8_LDA
#undef PG8_LDB
#undef PG8_MMA
#undef PG8_WAIT_V
#undef PG8_WAIT_L
#undef PG8_BAR
#undef PG8_SCHED
}
}
constexpr int NWAVES = 8, NTHR = 512;
constexpr int RING_OFF = 0, RING_BYTES = 131072;
constexpr int LDSCTL_OFF = RING_BYTES, MISC_OFF = LDSCTL_OFF + 320;
constexpr int LDS_BYTES = 147456;
constexpr int CW_BAR = 4096;
#define GAS __attribute__((address_space(1)))
#define LAS __attribute__((address_space(3)))
typedef unsigned short bf16;
typedef unsigned v4u __attribute__((ext_vector_type(4)));
typedef unsigned v2u __attribute__((ext_vector_type(2)));
typedef float f32x4 __attribute__((ext_vector_type(4)));
typedef short bf16x8 __attribute__((ext_vector_type(8)));
#define LDS_WAIT() asm volatile("s_waitcnt lgkmcnt(0)" ::: "memory")
#define VM_WAIT() asm volatile("s_waitcnt vmcnt(0)" ::: "memory")
__device__ __forceinline__ unsigned f2bf(float f) { unsigned u = __builtin_bit_cast(unsigned, f); return (u + 0x7fffu + ((u >> 16) & 1u)) >> 16; }
__device__ __forceinline__ unsigned pk2(float lo, float hi) { return f2bf(lo) | (f2bf(hi) << 16); }
__device__ __forceinline__ float bf2f(bf16 b) { return __builtin_bit_cast(float, (unsigned)b << 16); }
__device__ __forceinline__ float wave_sum(float v) {
#pragma unroll
    for (int o = 1; o < 64; o <<= 1) v += __shfl_xor(v, o);
    return v;
}
__device__ __forceinline__ float siluf(float x) { return x / (1.0f + __expf(-x)); }
__device__ __forceinline__ int opaque_tid() { int t = threadIdx.x; asm volatile("" : "+v"(t)); return t; }

struct Args { const float* in[N_IN]; float* out; unsigned char* ws; int ph_lo, ph_hi, coop, mask; };

constexpr int NPH = 2 + 9 * DEPTH;
typedef const Args __attribute__((address_space(4)))* KArgs;
__device__ __forceinline__ KArgs kargs() { const void __attribute__((address_space(4)))* p = (const void __attribute__((address_space(4)))*)__builtin_amdgcn_kernarg_segment_ptr(); asm volatile("" : "+s"(p)); return (KArgs)p; }

__device__ __forceinline__ void p0_transpose_item(const float* W, int ldw, int k0, int n_src0, bf16* WT, int Kdst, int dst_row0, float scale, LAS float* scr, int lane) {
#pragma unroll 8
    for (int i = 0; i < 32; ++i) { const int kk = 2 * i + (lane >> 5); scr[kk * 33 + (lane & 31)] = W[(size_t)(k0 + kk) * ldw + n_src0 + (lane & 31)]; }
    LDS_WAIT(); asm volatile("" ::: "memory");
    const int c = lane & 7;
#pragma unroll
    for (int j = 0; j < 4; ++j) { const int n = (lane >> 3) + 8 * j; const LAS float* s = scr + (8 * c) * 33 + n;
        v4u o; o.x = pk2(s[0 * 33] * scale, s[1 * 33] * scale); o.y = pk2(s[2 * 33] * scale, s[3 * 33] * scale); o.z = pk2(s[4 * 33] * scale, s[5 * 33] * scale); o.w = pk2(s[6 * 33] * scale, s[7 * 33] * scale);
        *(GAS v4u*)(WT + (size_t)(dst_row0 + n) * Kdst + k0 + 8 * c) = o; }
    LDS_WAIT(); asm volatile("" ::: "memory");
}

__device__ __forceinline__ void phase_p0a(KArgs a, LAS unsigned char* lds) {
    const int tid = opaque_tid(), lane = tid & 63, wave = tid >> 6;
    const int G = gridDim.x, gw = blockIdx.x * NWAVES + wave, NGW = G * NWAVES;
    unsigned char* ws = a->ws;
    LAS float* scr = (LAS float*)(lds + wave * 16384);
    constexpr int IT_IN = 16 * 88, IT_OUT = 16 * 32, IT_G = 16 * 88, IT_D = 44 * 32, IT_L = IT_IN + IT_OUT + 2 * IT_G + IT_D;
    for (int it = gw; it < DEPTH * IT_L; it += NGW) {
        const int l = it / IT_L; int r = it % IT_L;
        if (r < IT_IN) { const int kb = r / 88, nb = r % 88, n0 = nb * 32;
            const float sc = (n0 >= C_NQ && n0 < C_NK) ? 0.125f : (n0 >= C_RQ && n0 < C_RK) ? 0.125f : (n0 >= C_AQ && n0 < C_AK) ? 0.17677669529663687f : 1.0f;
            p0_transpose_item(a->in[I_WIN] + (size_t)l * D * PIN, PIN, kb * 64, n0, (bf16*)(ws + WS_W1 + l * W1_L), D, n0, sc, scr, lane); continue; }
        r -= IT_IN;
        if (r < IT_OUT) { const int kb = r / 32, nb = r % 32;
            p0_transpose_item(a->in[I_WOUT] + (size_t)l * D * D, D, kb * 64, nb * 32, (bf16*)(ws + WS_W2 + l * W2_L), D, nb * 32, 1.0f, scr, lane); continue; }
        r -= IT_OUT;
        if (r < 2 * IT_G) { const int up = r >= IT_G; if (up) r -= IT_G; const int kb = r / 88, nb = r % 88, n0 = nb * 32;
            p0_transpose_item((up ? a->in[I_WU] : a->in[I_WG]) + (size_t)l * D * DFF, DFF, kb * 64, n0, (bf16*)(ws + WS_W3 + l * W3_L), D, (n0 >> 7) * 256 + (up ? 128 : 0) + (n0 & 127), 1.0f, scr, lane); continue; }
        r -= 2 * IT_G;
        { const int kb = r / 32, nb = r % 32;
            p0_transpose_item(a->in[I_WD] + (size_t)l * DFF * D, D, kb * 64, nb * 32, (bf16*)(ws + WS_W4 + l * W4_L), DFF, nb * 32, 1.0f, scr, lane); }
    }
    for (int i = blockIdx.x * NTHR + tid; i < DEPTH * 256 * D; i += G * NTHR) {
        const int k = i & (D - 1), dj = (i >> 10) & 255, l = i >> 18;
        const float* wr = a->in[I_WIN] + ((size_t)l * D + k) * PIN + 2816; const float* gu = a->in[I_GUP] + (size_t)l * 2 * 16 * 128 + (dj >> 7) * 16 * 128 + (dj & 127);
        float s = 0.f;
#pragma unroll
        for (int r = 0; r < 16; ++r) s += wr[r] * gu[r * 128];
        ((bf16*)(ws + WS_W1 + l * W1_L))[(size_t)(2816 + dj) * D + k] = (bf16)f2bf(s);
    }
    for (int i = blockIdx.x * NTHR + tid; i < 1024; i += G * NTHR) { const int pos = i >> 4, j = i & 15; const float ang = (float)pos * powf(10000.0f, -(float)j / 16.0f); ((float2*)(ws + WS_ROPE))[i] = make_float2(cosf(ang), sinf(ang)); }
    __syncthreads();
    LAS float* sc = (LAS float*)lds;
    LAS float* red = (LAS float*)(lds + 16384);
    for (int i = tid; i < 3 * D; i += NTHR) { const int v = i >> 10, k = i & (D - 1); const float x = v == 0 ? a->in[I_CCTX][k] : a->in[I_C][(v - 1) * D + k]; sc[i] = siluf(x); }
    __syncthreads();
    float* MOD = (float*)(ws + WS_MOD);
    for (int it = blockIdx.x; it < DEPTH * 96; it += G) {
        const int l = it / 96, n0 = (it % 96) * 64;
        const float* w = a->in[I_WMOD] + (size_t)l * D * 6144 + (size_t)(wave * 128) * 6144 + n0 + lane;
        float a0 = 0.f, a1 = 0.f, a2 = 0.f;
#pragma unroll 8
        for (int k = 0; k < 128; ++k) { const float x = w[(size_t)k * 6144]; const int kk = wave * 128 + k; a0 += sc[kk] * x; a1 += sc[D + kk] * x; a2 += sc[2 * D + kk] * x; }
        red[(wave * 3 + 0) * 64 + lane] = a0; red[(wave * 3 + 1) * 64 + lane] = a1; red[(wave * 3 + 2) * 64 + lane] = a2;
        __syncthreads();
        if (tid < 192) { const int v = tid >> 6; float s = 0.f;
#pragma unroll
            for (int w8 = 0; w8 < 8; ++w8) s += red[(w8 * 3 + v) * 64 + lane];
            MOD[((size_t)l * 3 + v) * 6144 + n0 + lane] = s + a->in[I_BMOD][l * 6144 + n0 + lane]; }
        __syncthreads();
    }
}

__device__ __forceinline__ const float* mod_row(KArgs a, int l, int row) { const int mv = row < TC ? 0 : 1 + ((row - TC) >> 12); return (const float*)(a->ws + WS_MOD) + ((size_t)l * 3 + mv) * 6144; }
__device__ __forceinline__ const float* xin_row(KArgs a, int row) { return row < TC ? a->in[I_XP] + (size_t)row * D : a->in[I_XS] + (size_t)(row - TC) * D; }
__device__ __forceinline__ void phase_p0b(KArgs a) {
    const int tid = opaque_tid(), lane = tid & 63, wave = tid >> 6;
    const int gw = blockIdx.x * NWAVES + wave, NGW = gridDim.x * NWAVES;
    bf16* H = (bf16*)(a->ws + WS_H);
    for (int row = gw; row < T; row += NGW) {
        const float* mod = mod_row(a, 0, row);
        const f32x4* xr = (const f32x4*)xin_row(a, row) + lane;
        f32x4 v[4]; float s = 0.f;
#pragma unroll
        for (int j = 0; j < 4; ++j) { v[j] = xr[64 * j]; s += (v[j].x * v[j].x + v[j].y * v[j].y) + (v[j].z * v[j].z + v[j].w * v[j].w); }
        const float rstd = 1.0f / sqrtf(wave_sum(s) * (1.f / D) + RMS_EPS);
        unsigned long long* o8 = (unsigned long long*)(H + (size_t)row * D) + lane;
#pragma unroll
        for (int j = 0; j < 4; ++j) { const int c = 4 * lane + 256 * j;
            const f32x4 g = *(const f32x4*)(a->in[I_GPM] + c), sh = *(const f32x4*)(mod + c), scl = *(const f32x4*)(mod + D + c);
            const f32x4 h = v[j] * rstd * g * (scl + 1.0f) + sh;
            o8[64 * j] = (unsigned long long)pk2(h.x, h.y) | ((unsigned long long)pk2(h.z, h.w) << 32); }
    }
}
__device__ __forceinline__ void phase_rowpass(KArgs a, int l, int which) {
    const int tid = opaque_tid(), lane = tid & 63, wave = tid >> 6;
    const int gw = blockIdx.x * NWAVES + wave, NGW = gridDim.x * NWAVES;
    bf16* H = (bf16*)(a->ws + WS_H); const float* Y = (const float*)(a->ws + WS_Y);
    const float* gpost = (which ? a->in[I_GQF] : a->in[I_GQM]) + l * D;
    const bool need_h = (which == 0) || (l + 1 < DEPTH);
    const float* gpre = which == 0 ? a->in[I_GPF] + l * D : a->in[I_GPM] + (l + 1 < DEPTH ? l + 1 : l) * D;
    for (int row = gw; row < T; row += NGW) {
        const float* mod = mod_row(a, l, row);
        const float* modn = which == 0 ? mod : mod_row(a, l + 1 < DEPTH ? l + 1 : l, row);
        const f32x4* yr = (const f32x4*)(Y + (size_t)row * D) + lane;
        const f32x4* xr = (l == 0 && which == 0) ? (const f32x4*)xin_row(a, row) + lane : (const f32x4*)(a->out + (size_t)row * D) + lane;
        f32x4 y[4], x[4]; float s = 0.f;
#pragma unroll
        for (int j = 0; j < 4; ++j) { y[j] = yr[64 * j]; x[j] = xr[64 * j]; s += (y[j].x * y[j].x + y[j].y * y[j].y) + (y[j].z * y[j].z + y[j].w * y[j].w); }
        const float rstd = 1.0f / sqrtf(wave_sum(s) * (1.f / D) + RMS_EPS);
        float s2 = 0.f;
        f32x4* xo = (f32x4*)(a->out + (size_t)row * D) + lane;
#pragma unroll
        for (int j = 0; j < 4; ++j) { const int c = 4 * lane + 256 * j;
            const f32x4 g = *(const f32x4*)(gpost + c), gt = *(const f32x4*)(mod + (which ? 5 : 2) * D + c);
            x[j] = x[j] + gt * (y[j] * rstd * g);
            xo[64 * j] = x[j];
            s2 += (x[j].x * x[j].x + x[j].y * x[j].y) + (x[j].z * x[j].z + x[j].w * x[j].w); }
        if (need_h) {
            const float rstd2 = 1.0f / sqrtf(wave_sum(s2) * (1.f / D) + RMS_EPS);
            unsigned long long* o8 = (unsigned long long*)(H + (size_t)row * D) + lane;
#pragma unroll
            for (int j = 0; j < 4; ++j) { const int c = 4 * lane + 256 * j;
                const f32x4 g = *(const f32x4*)(gpre + c), sh = *(const f32x4*)(modn + (which == 0 ? 3 : 0) * D + c), scl = *(const f32x4*)(modn + (which == 0 ? 4 : 1) * D + c);
                const f32x4 h = x[j] * rstd2 * g * (scl + 1.0f) + sh;
                o8[64 * j] = (unsigned long long)pk2(h.x, h.y) | ((unsigned long long)pk2(h.z, h.w) << 32); }
        }
    }
}
#define XB_TMO      128
#define XB_XCNT(j)  (256  + 64 * (j))
#define XB_XSUB(j)  (1280 + 64 * (j))
#define XB_XGEN(j)  (2304 + 64 * (j))
#define XB_TOP      3328
#define XB_TOPGEN   3392
#define XCD_BAR_WORDS 3456
#define XB_SPIN_CAP (1u << 18)

__device__ __forceinline__ unsigned xb_ld(unsigned* p)              { return __hip_atomic_load(p, __ATOMIC_RELAXED, __HIP_MEMORY_SCOPE_AGENT); }
__device__ __forceinline__ unsigned xb_add(unsigned* p, unsigned v) { return __hip_atomic_fetch_add(p, v, __ATOMIC_RELAXED, __HIP_MEMORY_SCOPE_AGENT); }
__device__ __forceinline__ unsigned xb_xcc_id() { return (unsigned)__builtin_amdgcn_s_getreg((3 << 11) | 20) & 0xFu; }
#define XB_SPIN(cond, bar) do { unsigned _sp = 0; while (cond) { __builtin_amdgcn_s_sleep(1); \
    if ((++_sp & 255u) == 0u) { if (xb_ld(&(bar)[XB_TMO])) break; if (_sp > XB_SPIN_CAP) { atomicAdd(&(bar)[XB_TMO], 1u); break; } } } } while (0)

struct XcdBarrier {
    unsigned* bar; unsigned x;
    volatile LAS unsigned* st;
};

__device__ __forceinline__ XcdBarrier xcd_barrier_post(unsigned* bar, volatile LAS unsigned* st) {
    XcdBarrier b; b.bar = bar; b.x = xb_xcc_id(); b.st = st;
    if (threadIdx.x == 0) (void)xb_add(&bar[XB_XCNT(b.x)], 1u);
    return b;
}
__device__ __forceinline__ void xcd_barrier_complete(unsigned* bar, unsigned x, unsigned& nloc, unsigned& nx) {
    const unsigned G = gridDim.x * gridDim.y * gridDim.z;
    unsigned sum, cnt, mine, sp = 0u;
    for (;;) {
        sum = 0u; cnt = 0u; mine = 0u;
#pragma unroll
        for (unsigned j = 0; j < 16; ++j) { const unsigned c = xb_ld(&bar[XB_XCNT(j)]); sum += c; cnt += (c > 0u) ? 1u : 0u; mine = (j == x) ? c : mine; }
        if (sum == G) break;
        __builtin_amdgcn_s_sleep(1);
        if ((++sp & 255u) == 0u) { if (xb_ld(&bar[XB_TMO])) break; if (sp > XB_SPIN_CAP) { atomicAdd(&bar[XB_TMO], 1u); break; } }
    }
    nloc = mine > 0u ? mine : 1u; nx = cnt > 0u ? cnt : 1u;
}

__device__ __forceinline__ void xcd_barrier(const XcdBarrier& b) {
    asm volatile("s_waitcnt vmcnt(0)" ::: "memory");
    __syncthreads();
    if (threadIdx.x == 0) {
        unsigned* bar = b.bar;
        __builtin_amdgcn_s_waitcnt(0);
        unsigned nloc = b.st[0], nx = b.st[1];
        if (nloc == 0u) { xcd_barrier_complete(bar, b.x, nloc, nx); b.st[0] = nloc; b.st[1] = nx; }
        const unsigned old = xb_add(&bar[XB_XSUB(b.x)], 1u);
        const unsigned gen = old / nloc;
        if (old + 1u == (gen + 1u) * nloc) {
            __builtin_amdgcn_fence(__ATOMIC_RELEASE, "agent");
            asm volatile("s_waitcnt vmcnt(0)" ::: "memory");
            const unsigned og = xb_add(&bar[XB_TOP], 1u);
            const unsigned tg = og / nx;
            if (og + 1u == (tg + 1u) * nx) xb_add(&bar[XB_TOPGEN], 1u);
            else XB_SPIN(xb_ld(&bar[XB_TOPGEN]) == tg, bar);
            __builtin_amdgcn_fence(__ATOMIC_ACQUIRE, "agent");
            xb_add(&bar[XB_XGEN(b.x)], 1u);
            asm volatile("s_waitcnt vmcnt(0)" ::: "memory");
        } else {
            XB_SPIN(xb_ld(&bar[XB_XGEN(b.x)]) == gen, bar);
            __builtin_amdgcn_fence(__ATOMIC_ACQUIRE, "agent");
            asm volatile("s_waitcnt vmcnt(0)" ::: "memory");
        }
    }
    __syncthreads();
}
__device__ __forceinline__ f32x4 mfma16(bf16x8 a, bf16x8 b, f32x4 c) { return __builtin_amdgcn_mfma_f32_16x16x32_bf16(a, b, c, 0, 0, 0); }
__device__ __forceinline__ float grp16_max(float v) { v = fmaxf(v, __shfl_xor(v, 1)); v = fmaxf(v, __shfl_xor(v, 2)); v = fmaxf(v, __shfl_xor(v, 4)); v = fmaxf(v, __shfl_xor(v, 8)); return v; }
__device__ __forceinline__ float grp16_sum(float v) { v += __shfl_xor(v, 1); v += __shfl_xor(v, 2); v += __shfl_xor(v, 4); v += __shfl_xor(v, 8); return v; }
#define WAVE_SYNC() do { asm volatile("s_waitcnt lgkmcnt(0)" ::: "memory"); __builtin_amdgcn_wave_barrier(); asm volatile("" ::: "memory"); } while (0)
__device__ __forceinline__ v4u pack8(const float* f) { v4u o; o.x = pk2(f[0], f[1]); o.y = pk2(f[2], f[3]); o.z = pk2(f[4], f[5]); o.w = pk2(f[6], f[7]); return o; }
__device__ __forceinline__ void store_tile16x64(const f32x4 (&o)[4], LAS bf16* strip, int ld, bf16* gdst, size_t pitch, int lane) {
    const int fr = lane & 15, fq = lane >> 4;
#pragma unroll
    for (int nb = 0; nb < 4; ++nb)
#pragma unroll
        for (int j = 0; j < 4; ++j) strip[(4 * fq + j) * ld + nb * 16 + fr] = (bf16)f2bf(o[nb][j]);
    WAVE_SYNC();
    const int row = lane >> 2, c0 = (lane & 3) * 16;
    const v4u x0 = *(const LAS v4u*)(strip + row * ld + c0), x1 = *(const LAS v4u*)(strip + row * ld + c0 + 8);
    *(v4u*)(gdst + (size_t)row * pitch + c0) = x0; *(v4u*)(gdst + (size_t)row * pitch + c0 + 8) = x1;
    WAVE_SYNC();
}

constexpr int FA_Q = 0, FA_K = 18432, FA_VT = 36864, FA_P = 54272, FA_BIAS = 89088, FA_END = 91136;
template <bool LAT>
__device__ __forceinline__ void attn_item(KArgs a, int l, LAS unsigned char* lds, int item) {
    const int tid = opaque_tid(), lane = tid & 63, wave = tid >> 6, fr = lane & 15, fq = lane >> 4;
    const bf16* P = (const bf16*)(a->ws + WS_P); bf16* O = (bf16*)(a->ws + WS_O);
    LAS bf16* Qs = (LAS bf16*)(lds + FA_Q); LAS bf16* Ks = (LAS bf16*)(lds + FA_K); LAS bf16* Vt = (LAS bf16*)(lds + FA_VT);
    LAS bf16* Pw = (LAS bf16*)(lds + FA_P) + wave * (16 * 136); LAS float* bias = (LAS float*)(lds + FA_BIAS);
    int b, h, qtok0, R0 = 0, rp = 0;
    if (!LAT) { b = item >> 3; h = (item >> 1) & 3; qtok0 = b * 256 + (item & 1) * 128; }
    else { b = item >> 7; h = (item >> 5) & 3; rp = item & 31; qtok0 = TC + b * 4096 + rp * 128; R0 = min(max(2 * rp - 4, 0), 56); }
    __syncthreads();
#pragma unroll
    for (int i = tid; i < 1024; i += NTHR) { const int r = i >> 3, cc = i & 7; *(LAS v4u*)(Qs + r * 72 + cc * 8) = *(const v4u*)(P + (size_t)(qtok0 + r) * 3072 + C_NQ + h * 64 + cc * 8); }
    if (LAT) for (int i = tid; i < 465; i += NTHR) bias[i] = a->in[I_RPB][(size_t)(l * 4 + h) * 465 + i];
    float m[4], ls[4]; f32x4 o[4];
#pragma unroll
    for (int j = 0; j < 4; ++j) { m[j] = -1e30f; ls[j] = 0.f; o[j] = (f32x4){0.f, 0.f, 0.f, 0.f}; }
    const int qr = 2 * rp + (wave >> 2), r0q = min(max(qr - 4, 0), 56);
    const int nch = LAT ? 7 : 2;
    for (int ch = 0; ch < nch; ++ch) {
        if (ch) __syncthreads();
        if (LAT && ch < 2) {
            const float* ck = a->in[I_CK] + ((size_t)(b * 4 + l) * 256 + ch * 128) * 256 + h * 64; const float* cv = a->in[I_CV] + ((size_t)(b * 4 + l) * 256 + ch * 128) * 256 + h * 64;
#pragma unroll
            for (int i = tid; i < 1024; i += NTHR) { const int r = i >> 3, cc = i & 7; const f32x4 x0 = *(const f32x4*)(ck + (size_t)r * 256 + cc * 8), x1 = *(const f32x4*)(ck + (size_t)r * 256 + cc * 8 + 4);
                v4u w; w.x = pk2(x0.x, x0.y); w.y = pk2(x0.z, x0.w); w.z = pk2(x1.x, x1.y); w.w = pk2(x1.z, x1.w); *(LAS v4u*)(Ks + r * 72 + cc * 8) = w; }
#pragma unroll
            for (int i = tid; i < 1024; i += NTHR) { const int r = i & 127, cc = i >> 7; const f32x4 x0 = *(const f32x4*)(cv + (size_t)r * 256 + cc * 8), x1 = *(const f32x4*)(cv + (size_t)r * 256 + cc * 8 + 4);
                LAS bf16* d = Vt + (cc * 8) * 136 + r;
                d[0] = (bf16)f2bf(x0.x); d[136] = (bf16)f2bf(x0.y); d[272] = (bf16)f2bf(x0.z); d[408] = (bf16)f2bf(x0.w); d[544] = (bf16)f2bf(x1.x); d[680] = (bf16)f2bf(x1.y); d[816] = (bf16)f2bf(x1.z); d[952] = (bf16)f2bf(x1.w); }
        } else {
            const int c = ch - 2;
#pragma unroll
            for (int i = tid; i < 1024; i += NTHR) { const int r = i >> 3, cc = i & 7;
                const size_t tok = LAT ? (size_t)(TC + b * 4096 + min(R0 + 2 * c + (r >> 6), 63) * 64 + (r & 63)) : (size_t)(b * 256 + ch * 128 + r);
                *(LAS v4u*)(Ks + r * 72 + cc * 8) = *(const v4u*)(P + tok * 3072 + C_NK + h * 64 + cc * 8); }
#pragma unroll
            for (int i = tid; i < 1024; i += NTHR) { const int r = i & 127, cc = i >> 7;
                const size_t tok = LAT ? (size_t)(TC + b * 4096 + min(R0 + 2 * c + (r >> 6), 63) * 64 + (r & 63)) : (size_t)(b * 256 + ch * 128 + r);
                const v4u x = *(const v4u*)(P + tok * 3072 + C_NV + h * 64 + cc * 8);
                LAS bf16* d = Vt + (cc * 8) * 136 + r;
                d[0] = (bf16)(x.x & 0xffffu); d[136] = (bf16)(x.x >> 16); d[272] = (bf16)(x.y & 0xffffu); d[408] = (bf16)(x.y >> 16); d[544] = (bf16)(x.z & 0xffffu); d[680] = (bf16)(x.z >> 16); d[816] = (bf16)(x.w & 0xffffu); d[952] = (bf16)(x.w >> 16); }
        }
        __syncthreads();
        bf16x8 qa[2];
#pragma unroll
        for (int ks = 0; ks < 2; ++ks) qa[ks] = *(const LAS bf16x8*)(Qs + (16 * wave + fr) * 72 + ks * 32 + fq * 8);
        f32x4 s[8];
#pragma unroll
        for (int nb = 0; nb < 8; ++nb) { s[nb] = (f32x4){0.f, 0.f, 0.f, 0.f};
#pragma unroll
            for (int ks = 0; ks < 2; ++ks) s[nb] = mfma16(qa[ks], *(const LAS bf16x8*)(Ks + (nb * 16 + fr) * 72 + ks * 32 + fq * 8), s[nb]); }
        if (LAT && ch >= 2) {
            const int c = ch - 2;
#pragma unroll
            for (int j = 0; j < 4; ++j) { const int qc = (16 * wave + 4 * fq + j) & 63, c0q = min(max(qc - 8, 0), 48);
#pragma unroll
                for (int nb = 0; nb < 8; ++nb) { const int kr = R0 + 2 * c + (nb >> 2), kc = (nb & 3) * 16 + fr;
                    const bool ok = (kr >= r0q) && (kr < r0q + 8) && (kc >= c0q) && (kc < c0q + 16);
                    const int bi = ok ? (kr - qr + 7) * 31 + (kc - qc + 15) : 0;
                    s[nb][j] = ok ? s[nb][j] + bias[bi] : -1e30f; } }
        }
#pragma unroll
        for (int j = 0; j < 4; ++j) {
            float mx = s[0][j];
#pragma unroll
            for (int nb = 1; nb < 8; ++nb) mx = fmaxf(mx, s[nb][j]);
            mx = grp16_max(mx);
            const float mn = fmaxf(m[j], mx), al = __expf(m[j] - mn); m[j] = mn;
            float rs = 0.f;
#pragma unroll
            for (int nb = 0; nb < 8; ++nb) { const float p = __expf(s[nb][j] - mn); s[nb][j] = p; rs += p; }
            ls[j] = ls[j] * al + grp16_sum(rs);
#pragma unroll
            for (int nd = 0; nd < 4; ++nd) o[nd][j] *= al;
        }
#pragma unroll
        for (int nb = 0; nb < 8; ++nb)
#pragma unroll
            for (int j = 0; j < 4; ++j) Pw[(4 * fq + j) * 136 + nb * 16 + fr] = (bf16)f2bf(s[nb][j]);
        WAVE_SYNC();
#pragma unroll
        for (int ks = 0; ks < 4; ++ks) { const bf16x8 pa = *(const LAS bf16x8*)(Pw + fr * 136 + ks * 32 + fq * 8);
#pragma unroll
            for (int nd = 0; nd < 4; ++nd) o[nd] = mfma16(pa, *(const LAS bf16x8*)(Vt + (nd * 16 + fr) * 136 + ks * 32 + fq * 8), o[nd]); }
        WAVE_SYNC();
    }
#pragma unroll
    for (int j = 0; j < 4; ++j) { const float inv = 1.0f / ls[j];
#pragma unroll
        for (int nd = 0; nd < 4; ++nd) o[nd][j] *= inv; }
    store_tile16x64(o, Pw, 136, O + (size_t)(qtok0 + 16 * wave) * 1024 + 256 + h * 64, 1024, lane);
}
__device__ __forceinline__ void unpack8(v4u x, float* f) {
    f[0] = __builtin_bit_cast(float, x.x << 16); f[1] = __builtin_bit_cast(float, x.x & 0xffff0000u); f[2] = __builtin_bit_cast(float, x.y << 16); f[3] = __builtin_bit_cast(float, x.y & 0xffff0000u);
    f[4] = __builtin_bit_cast(float, x.z << 16); f[5] = __builtin_bit_cast(float, x.z & 0xffff0000u); f[6] = __builtin_bit_cast(float, x.w << 16); f[7] = __builtin_bit_cast(float, x.w & 0xffff0000u);
}
__device__ __forceinline__ float logsigf(float z) { return fminf(z, 0.f) - __logf(1.0f + __expf(-fabsf(z))); }
__device__ __forceinline__ void pool_item(KArgs a, int l, LAS unsigned char* lds, int item) {
    const int tid = opaque_tid(), lane = tid & 63, wave = tid >> 6, fr = lane & 15, fq = lane >> 4;
    const bf16* P = (const bf16*)(a->ws + WS_P); bf16* O = (bf16*)(a->ws + WS_O);
    LAS bf16* Vs = (LAS bf16*)lds; LAS bf16* Ds = (LAS bf16*)(lds + 36864); LAS bf16* Wt = (LAS bf16*)(lds + 73728);
    const int pm = item >> 2, g = item & 3, tok0 = pm * 256;
    __syncthreads();
#pragma unroll
    for (int i = tid; i < 2048; i += NTHR) { const int r = i >> 3, cc = i & 7; *(LAS v4u*)(Vs + r * 72 + cc * 8) = *(const v4u*)(P + (size_t)(tok0 + r) * 3072 + C_VP + g * 64 + cc * 8); }
    const float* pw = a->in[I_POOLW] + (size_t)(l * 4 + g) * 4096;
#pragma unroll
    for (int i = tid; i < 4096; i += NTHR) { const int c = i >> 6, dd = i & 63; Wt[dd * 72 + c] = (bf16)f2bf(pw[i]); }
    __syncthreads();
    const bool lat = pm >= 32; const int L = lat ? 64 : 256, win = 2 << g, left = win >> 1;
    for (int i = tid; i < 2048; i += NTHR) { const int t = i >> 3, cc = i & 7; const int pos = lat ? (t & 63) : t, base = t - pos;
        const int lo = max(pos - left, 0), hi = min(pos - left + win, L);
        float s[8], x[8];
#pragma unroll
        for (int e = 0; e < 8; ++e) s[e] = 0.f;
        for (int p = lo; p < hi; ++p) { unpack8(*(const LAS v4u*)(Vs + (base + p) * 72 + cc * 8), x);
#pragma unroll
            for (int e = 0; e < 8; ++e) s[e] += x[e]; }
        unpack8(*(const LAS v4u*)(Vs + t * 72 + cc * 8), x);
        const float inv = 1.0f / (float)(hi - lo);
#pragma unroll
        for (int e = 0; e < 8; ++e) s[e] = s[e] * inv - x[e];
        *(LAS v4u*)(Ds + t * 72 + cc * 8) = pack8(s); }
    __syncthreads();
    const float* psc = a->in[I_POOLS] + l * 256 + g * 64;
#pragma unroll
    for (int mb = 0; mb < 2; ++mb) { f32x4 y[4];
#pragma unroll
        for (int nb = 0; nb < 4; ++nb) y[nb] = (f32x4){0.f, 0.f, 0.f, 0.f};
#pragma unroll
        for (int ks = 0; ks < 2; ++ks) { const bf16x8 da = *(const LAS bf16x8*)(Ds + (32 * wave + 16 * mb + fr) * 72 + ks * 32 + fq * 8);
#pragma unroll
            for (int nb = 0; nb < 4; ++nb) y[nb] = mfma16(da, *(const LAS bf16x8*)(Wt + (nb * 16 + fr) * 72 + ks * 32 + fq * 8), y[nb]); }
#pragma unroll
        for (int nb = 0; nb < 4; ++nb) { const float sc = psc[nb * 16 + fr];
#pragma unroll
            for (int j = 0; j < 4; ++j) y[nb][j] *= sc; }
        store_tile16x64(y, Vs + wave * (16 * 72), 72, O + (size_t)(tok0 + 32 * wave + 16 * mb) * 1024 + g * 64, 1024, lane); }
}
__device__ __forceinline__ void rope_chunk8(const bf16* headrow, int cc, int n, const float2* tab, float* out) {
    float own[8], oth[8];
    unpack8(*(const v4u*)(headrow + cc * 8), own); unpack8(*(const v4u*)(headrow + (cc ^ 2) * 8), oth);
    const int pos = (cc & 4) ? (n & 63) : (n >> 6); const float2* t = tab + pos * 16 + (cc & 1) * 8;
    if (!(cc & 2)) {
#pragma unroll
        for (int e = 0; e < 8; ++e) out[e] = own[e] * t[e].x - oth[e] * t[e].y; }
    else {
#pragma unroll
        for (int e = 0; e < 8; ++e) out[e] = oth[e] * t[e].y + own[e] * t[e].x; }
}
__device__ __forceinline__ float sigmoidf_(float x) { return 1.0f / (1.0f + __expf(-x)); }
__device__ __forceinline__ void retu_item(KArgs a, int l, LAS unsigned char* lds, int item) {
    const int tid = opaque_tid(), lane = tid & 63, wave = tid >> 6, fr = lane & 15, fq = lane >> 4;
    const bf16* P = (const bf16*)(a->ws + WS_P); float* UR = (float*)(a->ws + WS_UR); const float2* tab = (const float2*)(a->ws + WS_ROPE);
    const int c = item >> 1, hp = item & 1, tok0 = c * 128; const bool lat = tok0 >= TC;
    __syncthreads();
#pragma unroll
    for (int hh = 0; hh < 2; ++hh) { const int h = 2 * hp + hh;
        LAS bf16* Ktf = (LAS bf16*)(lds + hh * 52224); LAS bf16* Ktb = Ktf + 64 * 136; LAS bf16* Vt = Ktb + 64 * 136;
        const float l2f = __log2f(sigmoidf_(a->in[I_RETL][(l * 2 + 0) * 4 + h])), l2b = __log2f(sigmoidf_(a->in[I_RETL][(l * 2 + 1) * 4 + h]));
#pragma unroll
        for (int i = tid; i < 1024; i += NTHR) { const int r = i & 127, cc = i >> 7; const bf16* rowp = P + (size_t)(tok0 + r) * 3072;
            float k[8];
            if (lat) rope_chunk8(rowp + C_RK + h * 64, cc, (tok0 + r - TC) & 4095, tab, k); else unpack8(*(const v4u*)(rowp + C_RK + h * 64 + cc * 8), k);
            const float wf = exp2f(l2f * (float)(127 - r)), wb = exp2f(l2b * (float)r);
            const v4u vx = *(const v4u*)(rowp + C_RV + h * 64 + cc * 8);
            LAS bf16* df = Ktf + (cc * 8) * 136 + r; LAS bf16* db = Ktb + (cc * 8) * 136 + r; LAS bf16* dv = Vt + (cc * 8) * 136 + r;
#pragma unroll
            for (int e = 0; e < 8; ++e) { df[e * 136] = (bf16)f2bf(k[e] * wf); db[e * 136] = (bf16)f2bf(k[e] * wb); }
            dv[0] = (bf16)(vx.x & 0xffffu); dv[136] = (bf16)(vx.x >> 16); dv[272] = (bf16)(vx.y & 0xffffu); dv[408] = (bf16)(vx.y >> 16); dv[544] = (bf16)(vx.z & 0xffffu); dv[680] = (bf16)(vx.z >> 16); dv[816] = (bf16)(vx.w & 0xffffu); dv[952] = (bf16)(vx.w >> 16); }
    }
    __syncthreads();
    { const int hh = wave >> 2, dir = (wave >> 1) & 1, mh = wave & 1, h = 2 * hp + hh;
      const LAS bf16* Kt = (const LAS bf16*)(lds + hh * 52224) + dir * (64 * 136); const LAS bf16* Vt = (const LAS bf16*)(lds + hh * 52224) + 2 * (64 * 136);
      float* dst = UR + ((size_t)(c * 4 + h) * 2 + dir) * 4096;
#pragma unroll
      for (int mi = 0; mi < 2; ++mi) { const int mb = 2 * mh + mi; f32x4 u[4];
#pragma unroll
          for (int nb = 0; nb < 4; ++nb) u[nb] = (f32x4){0.f, 0.f, 0.f, 0.f};
#pragma unroll
          for (int ks = 0; ks < 4; ++ks) { const bf16x8 ka = *(const LAS bf16x8*)(Kt + (mb * 16 + fr) * 136 + ks * 32 + fq * 8);
#pragma unroll
              for (int nb = 0; nb < 4; ++nb) u[nb] = mfma16(ka, *(const LAS bf16x8*)(Vt + (nb * 16 + fr) * 136 + ks * 32 + fq * 8), u[nb]); }
#pragma unroll
          for (int nb = 0; nb < 4; ++nb)
#pragma unroll
              for (int j = 0; j < 4; ++j) dst[(mb * 16 + 4 * fq + j) * 64 + nb * 16 + fr] = u[nb][j]; }
    }
}
constexpr int RO_Q = 0, RO_K = 18432, RO_VT = 36864, RO_P = 54272, RO_SF = 89088, RO_SB = 98304, RO_G = 107520;
__device__ __forceinline__ void reto_item(KArgs a, int l, LAS unsigned char* lds, int item) {
    const int tid = opaque_tid(), lane = tid & 63, wave = tid >> 6, fr = lane & 15, fq = lane >> 4;
    const bf16* P = (const bf16*)(a->ws + WS_P); bf16* O = (bf16*)(a->ws + WS_O); const float* SR = (const float*)(a->ws + WS_SR); const float2* tab = (const float2*)(a->ws + WS_ROPE);
    LAS bf16* Qs = (LAS bf16*)(lds + RO_Q); LAS bf16* Ks = (LAS bf16*)(lds + RO_K); LAS bf16* Vt = (LAS bf16*)(lds + RO_VT); LAS bf16* Pw = (LAS bf16*)(lds + RO_P) + wave * (16 * 136);
    LAS bf16* Sft = (LAS bf16*)(lds + RO_SF); LAS bf16* Sbt = (LAS bf16*)(lds + RO_SB); LAS bf16* Gs = (LAS bf16*)(lds + RO_G);
    const int c = item >> 2, h = item & 3, tok0 = c * 128; const bool lat = tok0 >= TC;
    const float l2f = __log2f(sigmoidf_(a->in[I_RETL][(l * 2 + 0) * 4 + h])), l2b = __log2f(sigmoidf_(a->in[I_RETL][(l * 2 + 1) * 4 + h]));
    __syncthreads();
#pragma unroll
    for (int i = tid; i < 1024; i += NTHR) { const int r = i >> 3, cc = i & 7; const bf16* rowp = P + (size_t)(tok0 + r) * 3072;
        if (lat) { float x[8]; rope_chunk8(rowp + C_RQ + h * 64, cc, (tok0 + r - TC) & 4095, tab, x); *(LAS v4u*)(Qs + r * 72 + cc * 8) = pack8(x);
                   rope_chunk8(rowp + C_RK + h * 64, cc, (tok0 + r - TC) & 4095, tab, x); *(LAS v4u*)(Ks + r * 72 + cc * 8) = pack8(x); }
        else { *(LAS v4u*)(Qs + r * 72 + cc * 8) = *(const v4u*)(rowp + C_RQ + h * 64 + cc * 8); *(LAS v4u*)(Ks + r * 72 + cc * 8) = *(const v4u*)(rowp + C_RK + h * 64 + cc * 8); }
        *(LAS v4u*)(Gs + r * 72 + cc * 8) = *(const v4u*)(rowp + C_RG + h * 64 + cc * 8); }
#pragma unroll
    for (int i = tid; i < 1024; i += NTHR) { const int r = i & 127, cc = i >> 7; const v4u vx = *(const v4u*)(P + (size_t)(tok0 + r) * 3072 + C_RV + h * 64 + cc * 8);
        LAS bf16* dv = Vt + (cc * 8) * 136 + r;
        dv[0] = (bf16)(vx.x & 0xffffu); dv[136] = (bf16)(vx.x >> 16); dv[272] = (bf16)(vx.y & 0xffffu); dv[408] = (bf16)(vx.y >> 16); dv[544] = (bf16)(vx.z & 0xffffu); dv[680] = (bf16)(vx.z >> 16); dv[816] = (bf16)(vx.w & 0xffffu); dv[952] = (bf16)(vx.w >> 16); }
    { const float* sf = SR + ((size_t)(c * 4 + h) * 2 + 0) * 4096; const float* sb = sf + 4096;
#pragma unroll
      for (int i = tid; i < 4096; i += NTHR) { const int dk = i >> 6, dv = i & 63; Sft[dv * 72 + dk] = (bf16)f2bf(sf[i]); Sbt[dv * 72 + dk] = (bf16)f2bf(sb[i]); } }
    __syncthreads();
    bf16x8 qa[2];
#pragma unroll
    for (int ks = 0; ks < 2; ++ks) qa[ks] = *(const LAS bf16x8*)(Qs + (16 * wave + fr) * 72 + ks * 32 + fq * 8);
    {   f32x4 s[8];
#pragma unroll
        for (int nb = 0; nb < 8; ++nb) { s[nb] = (f32x4){0.f, 0.f, 0.f, 0.f};
#pragma unroll
            for (int ks = 0; ks < 2; ++ks) s[nb] = mfma16(qa[ks], *(const LAS bf16x8*)(Ks + (nb * 16 + fr) * 72 + ks * 32 + fq * 8), s[nb]); }
#pragma unroll
        for (int nb = 0; nb < 8; ++nb)
#pragma unroll
            for (int j = 0; j < 4; ++j) { const int dd = (16 * wave + 4 * fq + j) - (nb * 16 + fr);
                const float wgt = dd > 0 ? exp2f(l2f * (float)dd) : (dd < 0 ? exp2f(l2b * (float)(-dd)) : 2.0f);
                Pw[(4 * fq + j) * 136 + nb * 16 + fr] = (bf16)f2bf(s[nb][j] * wgt); }
    }
    WAVE_SYNC();
    f32x4 o[4], of[4], ob[4];
#pragma unroll
    for (int nd = 0; nd < 4; ++nd) { o[nd] = (f32x4){0.f, 0.f, 0.f, 0.f}; of[nd] = o[nd]; ob[nd] = o[nd]; }
#pragma unroll
    for (int ks = 0; ks < 4; ++ks) { const bf16x8 pa = *(const LAS bf16x8*)(Pw + fr * 136 + ks * 32 + fq * 8);
#pragma unroll
        for (int nd = 0; nd < 4; ++nd) o[nd] = mfma16(pa, *(const LAS bf16x8*)(Vt + (nd * 16 + fr) * 136 + ks * 32 + fq * 8), o[nd]); }
#pragma unroll
    for (int ks = 0; ks < 2; ++ks)
#pragma unroll
        for (int nd = 0; nd < 4; ++nd) { of[nd] = mfma16(qa[ks], *(const LAS bf16x8*)(Sft + (nd * 16 + fr) * 72 + ks * 32 + fq * 8), of[nd]);
                                         ob[nd] = mfma16(qa[ks], *(const LAS bf16x8*)(Sbt + (nd * 16 + fr) * 72 + ks * 32 + fq * 8), ob[nd]); }
    WAVE_SYNC();
#pragma unroll
    for (int j = 0; j < 4; ++j) { const int i = 16 * wave + 4 * fq + j; const float wf = exp2f(l2f * (float)(i + 1)), wb = exp2f(l2b * (float)(128 - i));
        float sm = 0.f;
#pragma unroll
        for (int nd = 0; nd < 4; ++nd) { o[nd][j] += wf * of[nd][j] + wb * ob[nd][j]; sm += o[nd][j]; }
        const float mu = grp16_sum(sm) * (1.f / 64.f); float vs = 0.f;
#pragma unroll
        for (int nd = 0; nd < 4; ++nd) { o[nd][j] -= mu; vs += o[nd][j] * o[nd][j]; }
        const float rstd = 1.0f / sqrtf(grp16_sum(vs) * (1.f / 64.f) + GN_EPS);
#pragma unroll
        for (int nd = 0; nd < 4; ++nd) o[nd][j] *= rstd * siluf(bf2f(Gs[i * 72 + nd * 16 + fr])); }
    store_tile16x64(o, Pw, 136, O + (size_t)(tok0 + 16 * wave) * 1024 + 512 + h * 64, 1024, lane);
}
__device__ __forceinline__ void gla_gates(KArgs a, int l, int tok0, int h, LAS float* Bf, LAS float* Bb, int tid) {
    const float* LG = (const float*)(a->ws + WS_LG); const float* gb = a->in[I_GB] + l * 256 + h * 32;
#pragma unroll
    for (int i = tid; i < 4096; i += NTHR) { const int t = i >> 6, dir = (i >> 5) & 1, d = i & 31;
        const float z = LG[(size_t)(tok0 + t) * 256 + dir * 128 + h * 32 + d] + gb[dir * 128 + d];
        (dir ? Bb : Bf)[t * 33 + d] = logsigf(z) * 0.0625f; }
    __syncthreads();
    {
        const int lane = tid & 63, wave = tid >> 6; float v[8];
#pragma unroll
        for (int q = 0; q < 8; ++q) { const int col = 8 * wave + q, dir = col >> 5, d = col & 31; v[q] = (dir ? Bb : Bf)[(dir ? 63 - lane : lane) * 33 + d]; }
#pragma unroll
        for (int off = 1; off < 64; off <<= 1) {
#pragma unroll
            for (int q = 0; q < 8; ++q) { const float t = __shfl_up(v[q], off); if (lane >= off) v[q] += t; } }
#pragma unroll
        for (int q = 0; q < 8; ++q) { const int col = 8 * wave + q, dir = col >> 5, d = col & 31; (dir ? Bb : Bf)[(dir ? 63 - lane : lane) * 33 + d] = v[q]; }
    }
    __syncthreads();
}
__device__ __forceinline__ void glau_item(KArgs a, int l, LAS unsigned char* lds, int item) {
    const int tid = opaque_tid(), lane = tid & 63, wave = tid >> 6, fr = lane & 15, fq = lane >> 4;
    const bf16* P = (const bf16*)(a->ws + WS_P); float* UG = (float*)(a->ws + WS_UG); float* GG = (float*)(a->ws + WS_GG);
    LAS float* Bf = (LAS float*)lds; LAS float* Bb = (LAS float*)(lds + 8448); LAS bf16* Ktf = (LAS bf16*)(lds + 16896); LAS bf16* Ktb = (LAS bf16*)(lds + 21504); LAS bf16* Vt = (LAS bf16*)(lds + 26112);
    const int bk = item >> 2, h = item & 3, tok0 = bk * 64;
    __syncthreads();
    gla_gates(a, l, tok0, h, Bf, Bb, tid);
    if (tid < 256) { const int r = tid & 63, cc = tid >> 6; float k[8]; unpack8(*(const v4u*)(P + (size_t)(tok0 + r) * 3072 + C_AK + h * 32 + cc * 8), k);
#pragma unroll
        for (int e = 0; e < 8; ++e) { const int d = cc * 8 + e; Ktf[d * 72 + r] = (bf16)f2bf(k[e] * __expf(Bf[63 * 33 + d] - Bf[r * 33 + d])); Ktb[d * 72 + r] = (bf16)f2bf(k[e] * __expf(Bb[d] - Bb[r * 33 + d])); } }
    { const int r = tid & 63, cc = tid >> 6; const v4u vx = *(const v4u*)(P + (size_t)(tok0 + r) * 3072 + C_AV + h * 64 + cc * 8); LAS bf16* dv = Vt + (cc * 8) * 72 + r;
      dv[0] = (bf16)(vx.x & 0xffffu); dv[72] = (bf16)(vx.x >> 16); dv[144] = (bf16)(vx.y & 0xffffu); dv[216] = (bf16)(vx.y >> 16); dv[288] = (bf16)(vx.z & 0xffffu); dv[360] = (bf16)(vx.z >> 16); dv[432] = (bf16)(vx.w & 0xffffu); dv[504] = (bf16)(vx.w >> 16); }
    if (tid < 64) { const int dir = tid >> 5, d = tid & 31; GG[((size_t)(bk * 4 + h) * 2 + dir) * 32 + d] = __expf(dir ? Bb[d] : Bf[63 * 33 + d]); }
    __syncthreads();
    { const int dir = wave >> 2, mb = (wave >> 1) & 1, nh = wave & 1; const LAS bf16* Kt = dir ? Ktb : Ktf; float* dst = UG + ((size_t)(bk * 4 + h) * 2 + dir) * 2048;
      f32x4 u[2];
#pragma unroll
      for (int ni = 0; ni < 2; ++ni) u[ni] = (f32x4){0.f, 0.f, 0.f, 0.f};
#pragma unroll
      for (int ks = 0; ks < 2; ++ks) { const bf16x8 ka = *(const LAS bf16x8*)(Kt + (mb * 16 + fr) * 72 + ks * 32 + fq * 8);
#pragma unroll
          for (int ni = 0; ni < 2; ++ni) u[ni] = mfma16(ka, *(const LAS bf16x8*)(Vt + ((2 * nh + ni) * 16 + fr) * 72 + ks * 32 + fq * 8), u[ni]); }
#pragma unroll
      for (int ni = 0; ni < 2; ++ni)
#pragma unroll
          for (int j = 0; j < 4; ++j) dst[(mb * 16 + 4 * fq + j) * 64 + (2 * nh + ni) * 16 + fr] = u[ni][j]; }
}
__device__ __forceinline__ void glao_item(KArgs a, int l, LAS unsigned char* lds, int item) {
    const int tid = opaque_tid(), lane = tid & 63, wave = tid >> 6, fr = lane & 15, fq = lane >> 4;
    const bf16* P = (const bf16*)(a->ws + WS_P); bf16* O = (bf16*)(a->ws + WS_O); const float* SG = (const float*)(a->ws + WS_SG);
    LAS float* Bf = (LAS float*)lds; LAS float* Bb = (LAS float*)(lds + 8448);
    LAS bf16* Qf = (LAS bf16*)(lds + 16896); LAS bf16* Qb = (LAS bf16*)(lds + 22016); LAS bf16* Kf = (LAS bf16*)(lds + 27136); LAS bf16* Kb = (LAS bf16*)(lds + 32256);
    LAS bf16* Vt = (LAS bf16*)(lds + 37376); LAS bf16* Stf = (LAS bf16*)(lds + 46592); LAS bf16* Stb = (LAS bf16*)(lds + 51712); LAS bf16* Gs = (LAS bf16*)(lds + 56832);
    LAS bf16* Pw = (LAS bf16*)(lds + 66048) + (wave & 3) * (16 * 72);
    const int bk = item >> 2, h = item & 3, tok0 = bk * 64;
    __syncthreads();
    gla_gates(a, l, tok0, h, Bf, Bb, tid);
    if (tid < 256) { const int r = tid >> 2, cc = tid & 3; const bf16* rowp = P + (size_t)(tok0 + r) * 3072; float q[8], k[8], x[8];
        unpack8(*(const v4u*)(rowp + C_AQ + h * 32 + cc * 8), q); unpack8(*(const v4u*)(rowp + C_AK + h * 32 + cc * 8), k);
        float ef[8], eb[8];
#pragma unroll
        for (int e = 0; e < 8; ++e) { ef[e] = Bf[r * 33 + cc * 8 + e]; eb[e] = Bb[r * 33 + cc * 8 + e]; }
#pragma unroll
        for (int e = 0; e < 8; ++e) x[e] = q[e] * __expf(ef[e]);
        *(LAS v4u*)(Qf + r * 40 + cc * 8) = pack8(x);
#pragma unroll
        for (int e = 0; e < 8; ++e) x[e] = q[e] * __expf(eb[e]);
        *(LAS v4u*)(Qb + r * 40 + cc * 8) = pack8(x);
#pragma unroll
        for (int e = 0; e < 8; ++e) x[e] = k[e] * __expf(-ef[e]);
        *(LAS v4u*)(Kf + r * 40 + cc * 8) = pack8(x);
#pragma unroll
        for (int e = 0; e < 8; ++e) x[e] = k[e] * __expf(-eb[e]);
        *(LAS v4u*)(Kb + r * 40 + cc * 8) = pack8(x); }
    { const int r = tid & 63, cc = tid >> 6; const v4u vx = *(const v4u*)(P + (size_t)(tok0 + r) * 3072 + C_AV + h * 64 + cc * 8); LAS bf16* dv = Vt + (cc * 8) * 72 + r;
      dv[0] = (bf16)(vx.x & 0xffffu); dv[72] = (bf16)(vx.x >> 16); dv[144] = (bf16)(vx.y & 0xffffu); dv[216] = (bf16)(vx.y >> 16); dv[288] = (bf16)(vx.z & 0xffffu); dv[360] = (bf16)(vx.z >> 16); dv[432] = (bf16)(vx.w & 0xffffu); dv[504] = (bf16)(vx.w >> 16); }
    { const int r = tid >> 3, cc = tid & 7; *(LAS v4u*)(Gs + r * 72 + cc * 8) = *(const v4u*)(P + (size_t)(tok0 + r) * 3072 + C_AG + h * 64 + cc * 8); }
    { const float* sf = SG + ((size_t)(bk * 4 + h) * 2 + 0) * 2048; const float* sb = sf + 2048;
#pragma unroll
      for (int i = tid; i < 2048; i += NTHR) { const int dk = i >> 6, dv = i & 63; Stf[dv * 40 + dk] = (bf16)f2bf(sf[i]); Stb[dv * 40 + dk] = (bf16)f2bf(sb[i]); } }
    __syncthreads();
    if (wave < 4) {
        const int mb = wave;
        const bf16x8 qfa = *(const LAS bf16x8*)(Qf + (16 * mb + fr) * 40 + fq * 8), qba = *(const LAS bf16x8*)(Qb + (16 * mb + fr) * 40 + fq * 8);
#pragma unroll
        for (int nb = 0; nb < 4; ++nb) { const f32x4 z = (f32x4){0.f, 0.f, 0.f, 0.f};
            const f32x4 sf = mfma16(qfa, *(const LAS bf16x8*)(Kf + (nb * 16 + fr) * 40 + fq * 8), z), sb = mfma16(qba, *(const LAS bf16x8*)(Kb + (nb * 16 + fr) * 40 + fq * 8), z);
#pragma unroll
            for (int j = 0; j < 4; ++j) { const int i = 16 * mb + 4 * fq + j, jj = nb * 16 + fr; const float p = (jj <= i ? sf[j] : 0.f) + (jj >= i ? sb[j] : 0.f);
                Pw[(4 * fq + j) * 72 + nb * 16 + fr] = (bf16)f2bf(p); } }
        WAVE_SYNC();
        f32x4 o[4];
#pragma unroll
        for (int nd = 0; nd < 4; ++nd) o[nd] = (f32x4){0.f, 0.f, 0.f, 0.f};
#pragma unroll
        for (int ks = 0; ks < 2; ++ks) { const bf16x8 pa = *(const LAS bf16x8*)(Pw + fr * 72 + ks * 32 + fq * 8);
#pragma unroll
            for (int nd = 0; nd < 4; ++nd) o[nd] = mfma16(pa, *(const LAS bf16x8*)(Vt + (nd * 16 + fr) * 72 + ks * 32 + fq * 8), o[nd]); }
#pragma unroll
        for (int nd = 0; nd < 4; ++nd) { o[nd] = mfma16(qfa, *(const LAS bf16x8*)(Stf + (nd * 16 + fr) * 40 + fq * 8), o[nd]); o[nd] = mfma16(qba, *(const LAS bf16x8*)(Stb + (nd * 16 + fr) * 40 + fq * 8), o[nd]); }
        WAVE_SYNC();
        const float* ng = a->in[I_GNG] + l * 64;
#pragma unroll
        for (int j = 0; j < 4; ++j) { const int i = 16 * mb + 4 * fq + j; float ss = 0.f;
#pragma unroll
            for (int nd = 0; nd < 4; ++nd) ss += o[nd][j] * o[nd][j];
            const float rstd = 1.0f / sqrtf(grp16_sum(ss) * (1.f / 64.f) + RMS_EPS);
#pragma unroll
            for (int nd = 0; nd < 4; ++nd) o[nd][j] *= rstd * ng[nd * 16 + fr] * siluf(bf2f(Gs[i * 72 + nd * 16 + fr])); }
        store_tile16x64(o, Pw, 72, O + (size_t)(tok0 + 16 * mb) * 1024 + 768 + h * 64, 1024, lane);
    }
}
__device__ __forceinline__ void phase_m1b(KArgs a, int l) {
    const int tid = opaque_tid(); const int gt = blockIdx.x * NTHR + tid, NT = gridDim.x * NTHR;
    const float* UR = (const float*)(a->ws + WS_UR); float* SR = (float*)(a->ws + WS_SR); const float* UG = (const float*)(a->ws + WS_UG); float* SG = (float*)(a->ws + WS_SG); const float* GG = (const float*)(a->ws + WS_GG);
    const int mask = a->mask;
    if (mask & 8) for (int i = gt; i < 65536; i += NT) { const int e = i & 4095, dir = (i >> 12) & 1, h = (i >> 13) & 3, s = i >> 15;
        const float g128 = exp2f(128.0f * __log2f(sigmoidf_(a->in[I_RETL][(l * 2 + dir) * 4 + h])));
        float S = a->in[I_SR][((((size_t)s * 4 + l) * 2 + dir) * 4 + h) * 4096 + e];
        const size_t o0 = ((size_t)((64 + 32 * s) * 4 + h) * 2 + dir) * 4096 + e; constexpr size_t ST = (size_t)4 * 2 * 4096;
        float u[32];
#pragma unroll
        for (int n = 0; n < 32; ++n) u[n] = UR[o0 + (size_t)n * ST];
        if (!dir) {
#pragma unroll
            for (int n = 0; n < 32; ++n) { SR[o0 + (size_t)n * ST] = S; S = g128 * S + u[n]; } }
        else {
#pragma unroll
            for (int n = 31; n >= 0; --n) { SR[o0 + (size_t)n * ST] = S; S = g128 * S + u[n]; } } }
    if (mask & 8) for (int i = gt; i < 1048576; i += NT) { const int e = i & 4095, dir = (i >> 12) & 1, h = (i >> 13) & 3, b = i >> 15;
        const float g128 = exp2f(128.0f * __log2f(sigmoidf_(a->in[I_RETL][(l * 2 + dir) * 4 + h])));
        const int c1 = dir ? 2 * b + 1 : 2 * b, c2 = dir ? 2 * b : 2 * b + 1;
        const size_t o1 = ((size_t)(c1 * 4 + h) * 2 + dir) * 4096 + e, o2 = ((size_t)(c2 * 4 + h) * 2 + dir) * 4096 + e;
        const float u1 = UR[o1]; SR[o1] = 0.f; SR[o2] = u1;
        a->out[O_SR + ((((size_t)b * 4 + l) * 2 + dir) * 4 + h) * 4096 + e] = g128 * u1 + UR[o2]; }
    if (mask & 16) for (int i = gt; i < 32768; i += NT) { const int e = i & 2047, d = e >> 6, dir = (i >> 11) & 1, h = (i >> 12) & 3, s = i >> 14;
        float S = a->in[I_SG][((((size_t)s * 4 + l) * 2 + dir) * 4 + h) * 2048 + e];
        const size_t q0 = (size_t)((128 + 64 * s) * 4 + h) * 2 + dir;
        float u[64], gg[64];
#pragma unroll
        for (int n = 0; n < 64; ++n) { u[n] = UG[(q0 + 8 * n) * 2048 + e]; gg[n] = GG[(q0 + 8 * n) * 32 + d]; }
        if (!dir) {
#pragma unroll
            for (int n = 0; n < 64; ++n) { SG[(q0 + 8 * n) * 2048 + e] = S; S = gg[n] * S + u[n]; } }
        else {
#pragma unroll
            for (int n = 63; n >= 0; --n) { SG[(q0 + 8 * n) * 2048 + e] = S; S = gg[n] * S + u[n]; } } }
    if (mask & 16) for (int i = gt; i < 524288; i += NT) { const int e = i & 2047, d = e >> 6, dir = (i >> 11) & 1, h = (i >> 12) & 3, b = i >> 14;
        float S = 0.f;
#pragma unroll
        for (int n = 0; n < 4; ++n) { const int bk = 4 * b + (dir ? 3 - n : n); const size_t q = (size_t)(bk * 4 + h) * 2 + dir; SG[q * 2048 + e] = S; S = GG[q * 32 + d] * S + UG[q * 2048 + e]; }
        a->out[O_SG + ((((size_t)b * 4 + l) * 2 + dir) * 4 + h) * 2048 + e] = S; }
}
__device__ __forceinline__ void phase_m1(KArgs a, int l, LAS unsigned char* lds) {
    const int G = gridDim.x; const int mask = a->mask;
    if (mask & 2) for (int it = blockIdx.x; it < 256; it += G) attn_item<true>(a, l, lds, it);
    if (mask & 1) for (int it = blockIdx.x; it < 256; it += G) attn_item<false>(a, l, lds, it);
    if (mask & 8) for (int it = blockIdx.x; it < 256; it += G) retu_item(a, l, lds, it);
    if (mask & 16) for (int it = blockIdx.x; it < 1024; it += G) glau_item(a, l, lds, it);
    if (mask & 4) for (int it = blockIdx.x; it < 256; it += G) pool_item(a, l, lds, it);
    __syncthreads();
}
__device__ __forceinline__ void phase_m2(KArgs a, int l, LAS unsigned char* lds) {
    const int G = gridDim.x; const int mask = a->mask;
    if (mask & 32) for (int it = blockIdx.x; it < 512; it += G) reto_item(a, l, lds, it);
    if (mask & 64) for (int it = blockIdx.x; it < 1024; it += G) glao_item(a, l, lds, it);
    __syncthreads();
}
#ifndef REPMASK
#define REPMASK 0
#endif
__global__ void __launch_bounds__(NTHR, 2) mega(Args args) {
    extern __shared__ __attribute__((aligned(16))) unsigned char lds_raw[];
    LAS unsigned char* lds = (LAS unsigned char*)lds_raw;
    const int G = gridDim.x;
    if (threadIdx.x < 32) ((LAS unsigned*)(lds + LDSCTL_OFF))[threadIdx.x + 80] = 0u;
    __syncthreads();
    XcdBarrier bar; bar.bar = (unsigned*)(args.ws + WS_CTL) + CW_BAR; bar.x = 0; bar.st = nullptr;
    if (args.ph_hi - args.ph_lo > 1) bar = xcd_barrier_post((unsigned*)(args.ws + WS_CTL) + CW_BAR, (volatile LAS unsigned*)(lds + MISC_OFF) + 8);
    for (int ph = args.ph_lo; ph < args.ph_hi; ++ph) {
        const int kind = ph < 2 ? 9 + ph : (ph - 2) % 9; const int nrep = ((args.coop >> kind) & 1) ? 2 : 1;
        for (int rep = 0; rep < nrep; ++rep) {
        KArgs a = kargs(); unsigned char* ws = a->ws;
        if (rep) xcd_barrier(bar);
        if (ph == 0) phase_p0a(a, lds);
        else if (ph == 1) phase_p0b(a);
        else {
            const int l = (ph - 2) / 9, k = (ph - 2) % 9;
            if (k == 0) {
                pg8::Gemm g{(const pg8::bf16_t*)(ws + WS_H), (const pg8::bf16_t*)(ws + WS_W1 + l * W1_L), T, NP, D}; pg8::StaticOrder S; S.init(T, NP, G, (int)blockIdx.x);
                pg8::EpiG1 E{(pg8::bf16_t*)(ws + WS_P), (float*)(ws + WS_LG), a->out + O_CK, a->out + O_CV, l};
                pg8::gemm_phase<pg8::EpiG1, pg8::StaticOrder, true, true>(lds + RING_OFF, g, S, E);
            } else if (k == 4 || k == 7) {
                pg8::Gemm g = (k == 4) ? pg8::Gemm{(const pg8::bf16_t*)(ws + WS_O), (const pg8::bf16_t*)(ws + WS_W2 + l * W2_L), T, D, D}
                                       : pg8::Gemm{(const pg8::bf16_t*)(ws + WS_U3), (const pg8::bf16_t*)(ws + WS_W4 + l * W4_L), T, D, DFF};
                pg8::StaticOrder S; S.init(T, D, G, (int)blockIdx.x);
                pg8::EpiF32 E{(float*)(ws + WS_Y), D};
                pg8::gemm_phase<pg8::EpiF32, pg8::StaticOrder, true, true>(lds + RING_OFF, g, S, E);
            } else if (k == 6) {
                pg8::Gemm g{(const pg8::bf16_t*)(ws + WS_H), (const pg8::bf16_t*)(ws + WS_W3 + l * W3_L), T, N3, D}; pg8::StaticOrder S; S.init(T, N3, G, (int)blockIdx.x);
                pg8::EpiG3 E{(pg8::bf16_t*)(ws + WS_U3)};
                pg8::gemm_phase<pg8::EpiG3, pg8::StaticOrder, true, true>(lds + RING_OFF, g, S, E);
            } else if (k == 1) phase_m1(a, l, lds);
            else if (k == 2) phase_m1b(a, l);
            else if (k == 3) phase_m2(a, l, lds);
            else if (k == 5) phase_rowpass(a, l, 0);
            else if (k == 8) phase_rowpass(a, l, 1);
        }
        }
        if (ph + 1 < args.ph_hi) { if (ph == args.ph_lo) cg::this_grid().sync(); else xcd_barrier(bar); }
    }
}

extern "C" void kernel_launch(void* const* d_in, const int* in_sizes, int n_in, void* d_out, int out_size, void* d_ws, size_t ws_size, hipStream_t stream) {
    static int grid = 0;
    if (grid == 0) {
        if (n_in != N_IN || (size_t)out_size != O_END || ws_size < WS_END) { fprintf(stderr, "kernel_launch: unexpected shapes: n_in %d out %d ws %zu (need %zu)\n", n_in, out_size, ws_size, (size_t)WS_END); grid = -1; return; }
        int dev = 0, cus = 0, per_cu = 0;
        if (hipGetDevice(&dev) != hipSuccess || hipDeviceGetAttribute(&cus, hipDeviceAttributeMultiprocessorCount, dev) != hipSuccess) { grid = -1; return; }
        if (hipFuncSetAttribute((const void*)mega, hipFuncAttributeMaxDynamicSharedMemorySize, LDS_BYTES) != hipSuccess) { fprintf(stderr, "kernel_launch: hipFuncSetAttribute failed\n"); grid = -1; return; }
        if (hipOccupancyMaxActiveBlocksPerMultiprocessor(&per_cu, (const void*)mega, NTHR, LDS_BYTES) != hipSuccess || per_cu < 1) { fprintf(stderr, "kernel_launch: occupancy query says %d\n", per_cu); per_cu = 1; }
        (void)hipGetLastError();
        grid = cus;
    }
    if (grid < 0) return;
    if (hipMemsetAsync((char*)d_ws + WS_CTL, 0, CTL_ZERO_BYTES, stream) != hipSuccess) { fprintf(stderr, "kernel_launch: memset failed\n"); return; }
    Args a{};
    for (int i = 0; i < N_IN; ++i) a.in[i] = (const float*)d_in[i];
    a.out = (float*)d_out; a.ws = (unsigned char*)d_ws;
    unsigned char* ws = (unsigned char*)d_ws;
    auto run = [&](int lo, int hi, int mask = 0) {
        a.ph_lo = lo; a.ph_hi = hi; a.coop = REPMASK; a.mask = mask;
        if (hi - lo > 1) { void* args[] = {&a}; hipError_t e = hipLaunchCooperativeKernel((const void*)mega, dim3(grid), dim3(NTHR), args, LDS_BYTES, stream); if (e != hipSuccess) fprintf(stderr, "coop launch failed: %s\n", hipGetErrorString(e)); }
        else hipLaunchKernelGGL(mega, dim3(grid), dim3(NTHR), LDS_BYTES, stream, a);
    };
#ifndef MK_MULTI
#define MK_MULTI 0
#endif
    if (!MK_MULTI) { run(0, NPH, 127); return; }
    run(0, 2);
    for (int l = 0; l < DEPTH; ++l) { const int b = 2 + 9 * l; run(b, b + 1); run(b + 1, b + 2, 127); run(b + 2, b + 3, 127); run(b + 3, b + 4, 127); run(b + 4, b + 9); }
}
```
